# Optimizing an MI355X kernel written in HIP

```python
import math
import jax, jax.numpy as jnp
from jax import lax
import numpy as np

D_MODEL = 1024
BATCH = 8
SEQ = 4096
DEPTH = 4

CHUNK = 64
Q_BLOCK = 128
CONV_WIDTH = 3
A_GROUPS = 8
A_GROUP_DIM = D_MODEL // 16
A_DIM = A_GROUPS * A_GROUP_DIM
SGU_BLOCK = 128
B_GROUPS = 8
B_GROUP_DIM = D_MODEL // 16
B_DIM = B_GROUPS * B_GROUP_DIM
EVEN_IN = 3 * A_DIM + 2 * B_DIM
EVEN_MIX = A_DIM + B_DIM
MLA_HEADS = 8
MLA_NOPE_DIM = 64
MLA_ROPE_DIM = 32
MLA_V_DIM = 64
MLA_Q_RANK = 256
MLA_KV_RANK = 128
ROPE_THETA = 10000.0
FOX_HEADS = 8
FOX_HEAD_DIM = 64
FOX_DIM = FOX_HEADS * FOX_HEAD_DIM
FOX_BIAS_INIT = 3.0
ODD_IN = MLA_Q_RANK + MLA_KV_RANK + MLA_ROPE_DIM + 3 * FOX_DIM + FOX_HEADS
ODD_MIX = MLA_HEADS * MLA_V_DIM + FOX_DIM
N_EXPERTS = 32
TOP_K = 4
D_FF = D_MODEL
SWIGLU_ALPHA = 1.702
SWIGLU_LIMIT = 7.0
DN_ALPHA = (2 * DEPTH) ** 0.25
DN_BETA = (8 * DEPTH) ** -0.25
N_EVEN = (DEPTH + 1) // 2
N_ODD = DEPTH // 2
NORM_EPS = 1e-5
NEG_INF = -1e30

kernel_name = "hybrid_conv_sgu_mla_fox_moe_deepnorm"


def _layernorm(x, g, b):
    xf = x.astype(jnp.float32)
    mu = jnp.mean(xf, axis=-1, keepdims=True)
    var = jnp.mean(jnp.square(xf - mu), axis=-1, keepdims=True)
    return ((xf - mu) * lax.rsqrt(var + NORM_EPS) * g + b).astype(x.dtype)


def _rmsnorm(x, g):
    xf = x.astype(jnp.float32)
    ms = jnp.mean(jnp.square(xf), axis=-1, keepdims=True)
    return (xf * lax.rsqrt(ms + NORM_EPS) * g).astype(x.dtype)


def _rope(x):
    s, d = x.shape[1], x.shape[-1]
    inv_freq = ROPE_THETA ** (-jnp.arange(0, d, 2, dtype=jnp.float32) / d)
    ang = jnp.arange(s, dtype=jnp.float32)[:, None] * inv_freq[None, :]
    cos = jnp.cos(ang)[None, :, None, :]
    sin = jnp.sin(ang)[None, :, None, :]
    xf = x.astype(jnp.float32)
    x1, x2 = xf[..., : d // 2], xf[..., d // 2:]
    return jnp.concatenate([x1 * cos - x2 * sin, x2 * cos + x1 * sin], axis=-1).astype(x.dtype)


def _heads(t, h):
    b, s, _ = t.shape
    return t.reshape(b, s, h, -1).transpose(0, 2, 1, 3)


def _merge(t):
    b, h, s, d = t.shape
    return t.transpose(0, 2, 1, 3).reshape(b, s, h * d)


def _block_attention(q, k, v, scale, per_frame, log_f_cum=None):
    b, h, s, dq = q.shape
    dv = v.shape[-1]
    nb = s // Q_BLOCK
    k_pos = jnp.arange(s)
    q_blocks = jnp.moveaxis(q.reshape(b, h, nb, Q_BLOCK, dq), 2, 0)
    idx = jnp.arange(nb)

    def attend(qb, i, fq):
        q_pos = i * Q_BLOCK + jnp.arange(Q_BLOCK)
        logits = jnp.einsum('bhqd,bhkd->bhqk', qb, k).astype(jnp.float32) * scale
        if per_frame:
            allowed = k_pos[None, :] <= q_pos[:, None]
        else:
            allowed = (k_pos // CHUNK)[None, :] <= (q_pos // CHUNK)[:, None]
        if fq is not None:
            logits = logits + (fq[..., :, None] - log_f_cum[..., None, :])
        logits = jnp.where(allowed, logits, NEG_INF)
        p = jax.nn.softmax(logits, axis=-1).astype(v.dtype)
        return jnp.einsum('bhqk,bhkd->bhqd', p, v)

    if log_f_cum is None:
        out = lax.map(lambda xs: attend(xs[0], xs[1], None), (q_blocks, idx))
    else:
        f_blocks = jnp.moveaxis(log_f_cum.reshape(b, h, nb, Q_BLOCK), 2, 0)
        out = lax.map(lambda xs: attend(xs[0], xs[1], xs[2]), (q_blocks, idx, f_blocks))
    return jnp.moveaxis(out, 0, 2).reshape(b, h, s, dv)


def _even_mixer(x, w_in, conv_w, sgu_ln_g, sgu_ln_b, sgu_w, sgu_b, w_out):
    b, s, _ = x.shape
    proj = x @ w_in
    a_c, a_b, a_v, b_uv = jnp.split(proj, [A_DIM, 2 * A_DIM, 3 * A_DIM], axis=-1)
    h = a_c * a_v
    hp = jnp.pad(h, ((0, 0), (CONV_WIDTH - 1, 0), (0, 0)))
    conv = hp[:, 0:s] * conv_w[0] + hp[:, 1:s + 1] * conv_w[1] + hp[:, 2:s + 2] * conv_w[2]
    y_a = a_b * conv
    z = jax.nn.gelu(b_uv)
    u, v = jnp.split(z, 2, axis=-1)
    v = v.reshape(b, s // SGU_BLOCK, SGU_BLOCK, B_GROUPS, B_GROUP_DIM)
    v = _layernorm(v, sgu_ln_g.reshape(B_GROUPS, B_GROUP_DIM), sgu_ln_b.reshape(B_GROUPS, B_GROUP_DIM))
    pos = jnp.arange(SGU_BLOCK)
    mask = (pos[None, :] // CHUNK) <= (pos[:, None] // CHUNK)
    w_s = jnp.where(mask, sgu_w, 0.0)
    v = jnp.einsum('gij,bnjgc->bnigc', w_s, v) + sgu_b.T[:, :, None]
    y_b = u * v.reshape(b, s, B_DIM)
    return jnp.concatenate([y_a, y_b], axis=-1) @ w_out


def _odd_mixer(x, w_in, q_norm_g, kv_norm_g, w_uq, w_ukv, f_bias, w_out):
    b, s, _ = x.shape
    proj = x @ w_in
    splits = np.cumsum([MLA_Q_RANK, MLA_KV_RANK, MLA_ROPE_DIM, FOX_DIM, FOX_DIM, FOX_DIM]).tolist()
    c_q, c_kv, k_r, f_q, f_k, f_v, f_z = jnp.split(proj, splits, axis=-1)
    q = (_rmsnorm(c_q, q_norm_g) @ w_uq).reshape(b, s, MLA_HEADS, MLA_NOPE_DIM + MLA_ROPE_DIM)
    q = jnp.concatenate([q[..., :MLA_NOPE_DIM], _rope(q[..., MLA_NOPE_DIM:])], axis=-1)
    kv = (_rmsnorm(c_kv, kv_norm_g) @ w_ukv).reshape(b, s, MLA_HEADS, MLA_NOPE_DIM + MLA_V_DIM)
    k_nope, v_c = kv[..., :MLA_NOPE_DIM], kv[..., MLA_NOPE_DIM:]
    k_rope = jnp.broadcast_to(_rope(k_r[:, :, None, :]), (b, s, MLA_HEADS, MLA_ROPE_DIM))
    k = jnp.concatenate([k_nope, k_rope], axis=-1)
    y_c = _block_attention(q.transpose(0, 2, 1, 3), k.transpose(0, 2, 1, 3), v_c.transpose(0, 2, 1, 3),
                           1.0 / math.sqrt(MLA_NOPE_DIM + MLA_ROPE_DIM), per_frame=False)
    log_f = jax.nn.log_sigmoid((f_z + f_bias).astype(jnp.float32))
    log_f_cum = jnp.cumsum(log_f, axis=1).transpose(0, 2, 1)
    y_d = _block_attention(_heads(f_q, FOX_HEADS), _heads(f_k, FOX_HEADS), _heads(f_v, FOX_HEADS),
                           1.0 / math.sqrt(FOX_HEAD_DIM), per_frame=True, log_f_cum=log_f_cum)
    return jnp.concatenate([_merge(y_c), _merge(y_d)], axis=-1) @ w_out


def _clamped_swiglu(h):
    glu, lin = h[..., ::2], h[..., 1::2]
    glu = jnp.minimum(glu, SWIGLU_LIMIT)
    lin = jnp.clip(lin, -SWIGLU_LIMIT, SWIGLU_LIMIT)
    return glu * jax.nn.sigmoid(SWIGLU_ALPHA * glu) * (lin + 1.0)


def _moe(x, w_router, b_router, w1, b1, w2, b2):
    b, s, d = x.shape
    xt = x.reshape(b * s, d)
    logits = (xt @ w_router + b_router).astype(jnp.float32)
    top_val, top_idx = lax.top_k(logits, TOP_K)
    top_w = jax.nn.softmax(top_val, axis=-1)
    gates = jnp.einsum('nk,nke->ne', top_w, jax.nn.one_hot(top_idx, N_EXPERTS, dtype=jnp.float32)).astype(x.dtype)
    out = jnp.zeros_like(xt)
    for e in range(N_EXPERTS):
        h = _clamped_swiglu(xt @ w1[e] + b1[e])
        out = out + gates[:, e:e + 1] * (h @ w2[e] + b2[e])
    return out.reshape(b, s, d)


def setup_inputs(seed: int = 0) -> dict:
    key = jax.random.key(seed)
    ks = jax.random.split(key, 32)
    nrm = jax.random.normal
    f32 = jnp.float32
    return {
        "x": nrm(ks[0], (BATCH, SEQ, D_MODEL), f32),
        "ev_w_in": nrm(ks[1], (N_EVEN, D_MODEL, EVEN_IN), f32) * D_MODEL ** -0.5,
        "ev_conv_w": nrm(ks[2], (N_EVEN, CONV_WIDTH, A_DIM), f32) * CONV_WIDTH ** -0.5,
        "ev_sgu_ln_g": 1.0 + 0.1 * nrm(ks[3], (N_EVEN, B_DIM), f32),
        "ev_sgu_ln_b": 0.1 * nrm(ks[4], (N_EVEN, B_DIM), f32),
        "ev_sgu_w": nrm(ks[5], (N_EVEN, B_GROUPS, SGU_BLOCK, SGU_BLOCK), f32) * SGU_BLOCK ** -0.5,
        "ev_sgu_b": 1.0 + 0.1 * nrm(ks[6], (N_EVEN, B_GROUPS, SGU_BLOCK), f32),
        "ev_w_out": nrm(ks[7], (N_EVEN, EVEN_MIX, D_MODEL), f32) * EVEN_MIX ** -0.5 * DN_BETA,
        "od_w_in": nrm(ks[8], (N_ODD, D_MODEL, ODD_IN), f32) * D_MODEL ** -0.5,
        "od_q_norm_g": 1.0 + 0.1 * nrm(ks[9], (N_ODD, MLA_Q_RANK), f32),
        "od_kv_norm_g": 1.0 + 0.1 * nrm(ks[10], (N_ODD, MLA_KV_RANK), f32),
        "od_w_uq": nrm(ks[11], (N_ODD, MLA_Q_RANK, MLA_HEADS * (MLA_NOPE_DIM + MLA_ROPE_DIM)), f32) * MLA_Q_RANK ** -0.5,
        "od_w_ukv": nrm(ks[12], (N_ODD, MLA_KV_RANK, MLA_HEADS * (MLA_NOPE_DIM + MLA_V_DIM)), f32) * MLA_KV_RANK ** -0.5,
        "od_f_bias": FOX_BIAS_INIT + 0.5 * nrm(ks[13], (N_ODD, FOX_HEADS), f32),
        "od_w_out": nrm(ks[14], (N_ODD, ODD_MIX, D_MODEL), f32) * ODD_MIX ** -0.5 * DN_BETA,
        "ln_mix_g": 1.0 + 0.1 * nrm(ks[15], (DEPTH, D_MODEL), f32),
        "ln_mix_b": 0.1 * nrm(ks[16], (DEPTH, D_MODEL), f32),
        "ln_ffn_g": 1.0 + 0.1 * nrm(ks[17], (DEPTH, D_MODEL), f32),
        "ln_ffn_b": 0.1 * nrm(ks[18], (DEPTH, D_MODEL), f32),
        "moe_w_router": nrm(ks[19], (DEPTH, D_MODEL, N_EXPERTS), f32) * D_MODEL ** -0.5,
        "moe_b_router": 0.01 * nrm(ks[20], (DEPTH, N_EXPERTS), f32),
        "moe_w1": nrm(ks[21], (DEPTH, N_EXPERTS, D_MODEL, 2 * D_FF), f32) * D_MODEL ** -0.5,
        "moe_b1": 0.01 * nrm(ks[22], (DEPTH, N_EXPERTS, 2 * D_FF), f32),
        "moe_w2": nrm(ks[23], (DEPTH, N_EXPERTS, D_FF, D_MODEL), f32) * D_FF ** -0.5 * DN_BETA,
        "moe_b2": 0.01 * nrm(ks[24], (DEPTH, N_EXPERTS, D_MODEL), f32),
    }


def reference(x, ev_w_in, ev_conv_w, ev_sgu_ln_g, ev_sgu_ln_b, ev_sgu_w, ev_sgu_b, ev_w_out,
              od_w_in, od_q_norm_g, od_kv_norm_g, od_w_uq, od_w_ukv, od_f_bias, od_w_out,
              ln_mix_g, ln_mix_b, ln_ffn_g, ln_ffn_b,
              moe_w_router, moe_b_router, moe_w1, moe_b1, moe_w2, moe_b2):
    for layer in range(DEPTH):
        i = layer // 2
        if layer % 2 == 0:
            mix = _even_mixer(x, ev_w_in[i], ev_conv_w[i], ev_sgu_ln_g[i], ev_sgu_ln_b[i],
                              ev_sgu_w[i], ev_sgu_b[i], ev_w_out[i])
        else:
            mix = _odd_mixer(x, od_w_in[i], od_q_norm_g[i], od_kv_norm_g[i], od_w_uq[i],
                             od_w_ukv[i], od_f_bias[i], od_w_out[i])
        x = _layernorm(DN_ALPHA * x + mix, ln_mix_g[layer], ln_mix_b[layer])
        ffn = _moe(x, moe_w_router[layer], moe_b_router[layer], moe_w1[layer], moe_b1[layer],
                   moe_w2[layer], moe_b2[layer])
        x = _layernorm(DN_ALPHA * x + ffn, ln_ffn_g[layer], ln_ffn_b[layer])
    return x
```

```cpp
#include <hip/hip_runtime.h>
#include <cstdio>
#include <cstdint>

#define LAS __attribute__((address_space(3)))
#define GAS __attribute__((address_space(1)))
typedef unsigned short bf16;
typedef short bf16x8 __attribute__((ext_vector_type(8)));
typedef short s16x4 __attribute__((ext_vector_type(4)));
typedef float f32x2 __attribute__((ext_vector_type(2)));
typedef float f32x4 __attribute__((ext_vector_type(4)));
typedef float f32x16 __attribute__((ext_vector_type(16)));
typedef unsigned u32x2 __attribute__((ext_vector_type(2)));
typedef unsigned u32x4 __attribute__((ext_vector_type(4)));
typedef int i32x8 __attribute__((ext_vector_type(8)));

constexpr int NTOK = 32768, DM = 1024, SEQ = 4096, NBATCH = 8, DEPTH = 4;
constexpr int EVEN_IN = 2560, ODD_IN = 1960, ODD_INP = 2048;
constexpr int ODD_LD = 2112;
constexpr int NEXP = 32, TOPK = 4, DFF = 1024, CAP = 32768;
constexpr int HROWS = NTOK * TOPK + NEXP * 256;
constexpr float DN_ALPHA = 1.681792830507429f;
constexpr float LN_EPS = 1e-5f;
constexpr float LOG2E = 1.4426950408889634f;
constexpr float MLA_QS = 0.10206207261596575f * LOG2E;
constexpr float FOX_QS = 0.125f * LOG2E;

constexpr size_t MiB = 1u << 20;
constexpr size_t WS_CTL = 0, CTL_ZERO_BYTES = 160 * 1024;
constexpr size_t WS_ROPE = 1 * MiB;
constexpr size_t WS_WRT = 2 * MiB;
constexpr size_t WS_B1P = 3 * MiB;
constexpr size_t WS_SGUW = 4 * MiB;
constexpr size_t WS_FB = 5 * MiB;
constexpr size_t WS_FZ = 6 * MiB;
constexpr size_t WS_TOKINFO = 7 * MiB;
constexpr size_t WS_KROPE = 8 * MiB;
constexpr size_t WS_LIST = 10 * MiB;
constexpr size_t WS_GLIST = 14 * MiB;
constexpr size_t WS_UQT = 18 * MiB;
constexpr size_t WS_UKVT = 19 * MiB;
constexpr size_t WS_EVIN = 20 * MiB;
constexpr size_t WS_EVOUT = 30 * MiB;
constexpr size_t WS_ODIN = 34 * MiB;
constexpr size_t WS_ODOUT = 42 * MiB;
constexpr size_t WS_W1T = 64 * MiB;
constexpr size_t WS_W2T = 576 * MiB;
constexpr size_t WS_XB = 832 * MiB;
constexpr size_t WS_PROJ = 896 * MiB;
constexpr size_t WS_Y = 1056 * MiB;
constexpr size_t WS_PRE = 1120 * MiB;
constexpr size_t WS_H = 1248 * MiB;
constexpr size_t WS_OUT2 = 1520 * MiB;
constexpr size_t WS_Q = 1792 * MiB;
constexpr size_t WS_KV = 1840 * MiB;
constexpr size_t WS_CQN = 1904 * MiB;
constexpr size_t WS_CKVN = 1920 * MiB;
constexpr size_t WS_X8 = 1936 * MiB;
constexpr size_t WS_XL = 1968 * MiB;
constexpr size_t WS_END = 2032 * MiB;
static_assert(WS_H + (size_t)HROWS * 2048 <= WS_OUT2 && WS_OUT2 + (size_t)HROWS * 2048 <= WS_Q, "ws map");
constexpr int CW_BAR = 4096;
constexpr int CW_CNT = 16384;
constexpr int CNT_STRIDE = 64;
constexpr int CW_AQ = 36864;
constexpr int CW_KMAX = 32768;
constexpr int LDS_BYTES = 163840;
constexpr int EPI_LDS_OFF = 139264;
constexpr int MISC_OFF = LDS_BYTES - 256;

__device__ __forceinline__ float bf2f(unsigned b) { return __uint_as_float(b << 16); }
__device__ __forceinline__ unsigned f2bf(float f) { unsigned u = __float_as_uint(f); return (u + 0x7fffu + ((u >> 16) & 1u)) >> 16; }
__device__ __forceinline__ unsigned cvt_pk_bf16(float lo, float hi) { unsigned r; asm volatile("v_cvt_pk_bf16_f32 %0, %1, %2" : "=v"(r) : "v"(lo), "v"(hi)); return r; }
__device__ __forceinline__ float wave_sum(float v) {
    v += __builtin_bit_cast(float, __builtin_amdgcn_update_dpp(0, __builtin_bit_cast(int, v), 0xB1, 0xF, 0xF, true));
    v += __builtin_bit_cast(float, __builtin_amdgcn_update_dpp(0, __builtin_bit_cast(int, v), 0x4E, 0xF, 0xF, true));
    v += __builtin_bit_cast(float, __builtin_amdgcn_update_dpp(0, __builtin_bit_cast(int, v), 0x141, 0xF, 0xF, true));
    v += __builtin_bit_cast(float, __builtin_amdgcn_update_dpp(0, __builtin_bit_cast(int, v), 0x140, 0xF, 0xF, true));
    { auto rr = __builtin_amdgcn_permlane16_swap(__float_as_uint(v), __float_as_uint(v), false, false); v = __uint_as_float(rr[0]) + __uint_as_float(rr[1]); }
    { auto rr = __builtin_amdgcn_permlane32_swap(__float_as_uint(v), __float_as_uint(v), false, false); v = __uint_as_float(rr[0]) + __uint_as_float(rr[1]); }
    return v;
}
template <int CTRL> __device__ __forceinline__ float dpp_f(float x) { return __builtin_bit_cast(float, __builtin_amdgcn_update_dpp(0, __builtin_bit_cast(int, x), CTRL, 0xF, 0xF, true)); }
template <int CTRL> __device__ __forceinline__ f32x4 quad_piece(f32x4 a, f32x4 b, bool odd) {
    const float ax = dpp_f<CTRL>(a.x), ay = dpp_f<CTRL>(a.y), az = dpp_f<CTRL>(a.z), aw = dpp_f<CTRL>(a.w), bx = dpp_f<CTRL>(b.x), by = dpp_f<CTRL>(b.y), bz = dpp_f<CTRL>(b.z), bw = dpp_f<CTRL>(b.w);
    f32x4 r; r.x = odd ? bx : ax; r.y = odd ? by : ay; r.z = odd ? bz : az; r.w = odd ? bw : aw;
    return r;
}
__device__ __forceinline__ float gelu_tanh(float x) {
    const float u = 0.7978845608028654f * (x + 0.044715f * x * x * x);
    return x * __builtin_amdgcn_rcpf(1.0f + __builtin_amdgcn_exp2f(-2.0f * LOG2E * u));
}

#define XB_TMO      128
#define XB_XCNT(j)  (256  + 64 * (j))
#define XB_XSUB(j)  (1280 + 64 * (j))
#define XB_XGEN(j)  (2304 + 64 * (j))
#define XB_TOP      3328
#define XB_TOPGEN   3392
#define XCD_BAR_WORDS 3456
#define XB_SPIN_CAP (1u << 18)

__device__ __forceinline__ unsigned xb_ld(unsigned* p)              { return __hip_atomic_load(p, __ATOMIC_RELAXED, __HIP_MEMORY_SCOPE_AGENT); }
__device__ __forceinline__ unsigned xb_add(unsigned* p, unsigned v) { return __hip_atomic_fetch_add(p, v, __ATOMIC_RELAXED, __HIP_MEMORY_SCOPE_AGENT); }
__device__ __forceinline__ unsigned xb_xcc_id() { return (unsigned)__builtin_amdgcn_s_getreg((3 << 11) | 20) & 0xFu; }
#define XB_SPIN(cond, bar) do { unsigned _sp = 0; while (cond) { __builtin_amdgcn_s_sleep(1); \
    if ((++_sp & 255u) == 0u) { if (xb_ld(&(bar)[XB_TMO])) break; if (_sp > XB_SPIN_CAP) { atomicAdd(&(bar)[XB_TMO], 1u); break; } } } } while (0)

struct XcdBarrier { unsigned* bar; unsigned x; volatile LAS unsigned* st; };

__device__ __forceinline__ XcdBarrier xcd_barrier_post(unsigned* bar, volatile LAS unsigned* st) {
    XcdBarrier b; b.bar = bar; b.x = xb_xcc_id(); b.st = st;
    if (threadIdx.x == 0) (void)xb_add(&bar[XB_XCNT(b.x)], 1u);
    return b;
}
__device__ __forceinline__ void xcd_barrier_complete(unsigned* bar, unsigned x, unsigned& nloc, unsigned& nx) {
    const unsigned G = gridDim.x * gridDim.y * gridDim.z;
    unsigned sum, cnt, mine, sp = 0u;
    for (;;) {
        sum = 0u; cnt = 0u; mine = 0u;
#pragma unroll
        for (unsigned j = 0; j < 16; ++j) { const unsigned c = xb_ld(&bar[XB_XCNT(j)]); sum += c; cnt += (c > 0u) ? 1u : 0u; mine = (j == x) ? c : mine; }
        if (sum == G) break;
        __builtin_amdgcn_s_sleep(1);
        if ((++sp & 255u) == 0u) { if (xb_ld(&bar[XB_TMO])) break; if (sp > XB_SPIN_CAP) { atomicAdd(&bar[XB_TMO], 1u); break; } }
    }
    nloc = mine > 0u ? mine : 1u; nx = cnt > 0u ? cnt : 1u;
}
__device__ __forceinline__ void xcd_barrier(const XcdBarrier& b) {
    asm volatile("s_waitcnt vmcnt(0)" ::: "memory");
    __syncthreads();
    if (threadIdx.x == 0) {
        unsigned* bar = b.bar;
        __builtin_amdgcn_s_waitcnt(0);
        unsigned nloc = b.st[0], nx = b.st[1];
        if (nloc == 0u) { xcd_barrier_complete(bar, b.x, nloc, nx); b.st[0] = nloc; b.st[1] = nx; }
        const unsigned old = xb_add(&bar[XB_XSUB(b.x)], 1u);
        const unsigned gen = old / nloc;
        if (old + 1u == (gen + 1u) * nloc) {
            __builtin_amdgcn_fence(__ATOMIC_RELEASE, "agent");
            asm volatile("s_waitcnt vmcnt(0)" ::: "memory");
            const unsigned og = xb_add(&bar[XB_TOP], 1u);
            const unsigned tg = og / nx;
            if (og + 1u == (tg + 1u) * nx) xb_add(&bar[XB_TOPGEN], 1u);
            else XB_SPIN(xb_ld(&bar[XB_TOPGEN]) == tg, bar);
            __builtin_amdgcn_fence(__ATOMIC_ACQUIRE, "agent");
            xb_add(&bar[XB_XGEN(b.x)], 1u);
            asm volatile("s_waitcnt vmcnt(0)" ::: "memory");
        } else {
            XB_SPIN(xb_ld(&bar[XB_XGEN(b.x)]) == gen, bar);
            __builtin_amdgcn_fence(__ATOMIC_ACQUIRE, "agent");
            asm volatile("s_waitcnt vmcnt(0)" ::: "memory");
        }
    }
    __syncthreads();
}

namespace pg8 {
constexpr int BM = 256, BK = 64, HALF = 128, HTB = HALF * BK * 2, STAGE_BYTES = 8 * HTB, NXCD = 8, WGM = 8;
__host__ __device__ __forceinline__ int lds_byte(int r, int c) { const int st = (r >> 4) * 2 + (c >> 5), rr = r & 15, cc = c & 31, ob = rr * 64 + cc * 2; return st * 1024 + (ob ^ (((ob >> 9) & 1) << 5)); }
__host__ __device__ __forceinline__ void stage_rc(int b, int& R, int& C) { const int st = b / 1024, sb = b % 1024, swz = sb ^ (((sb >> 9) & 1) << 5); R = (st >> 1) * 16 + swz / 64; C = (st & 1) * 32 + (swz % 64) / 2; }
__host__ __device__ __forceinline__ int lds_byte8(int r, int cb) { const int st = (r >> 4) * 2 + (cb >> 6), rr = r & 15, ob = rr * 64 + (cb & 63); return st * 1024 + (ob ^ (((ob >> 9) & 1) << 4)); }
__host__ __device__ __forceinline__ void stage_rc8(int b, int& R, int& CB) { const int st = b / 1024, sb = b % 1024, swz = sb ^ (((sb >> 9) & 1) << 4); R = (st >> 1) * 16 + swz / 64; CB = (st & 1) * 64 + (swz % 64); }
__host__ __device__ __forceinline__ int perm32(int rho) { const int n = rho >> 4, i = rho & 15; return 8 * (i >> 2) + 4 * n + (i & 3); }

struct GUnit { const char* A; const char* B; int row0, col0, nvalid, e, lrow0, pad; };

struct DenseOrder {
    int nM, nN, nwg, G, c, nsplit; const char* A; const char* B; const char* A2; const char* B2; size_t astep, bstep;
    __device__ __forceinline__ void init(int M, int N, int G_, int c_, const void* A_, const void* B_, size_t astep_, size_t bstep_) {
        nM = M / BM; nN = N / BM; nwg = nM * nN; G = G_; c = c_; nsplit = nN; A = (const char*)A_; B = (const char*)B_; A2 = A; B2 = B; astep = astep_; bstep = bstep_; }
    __device__ __forceinline__ bool next(int i, GUnit& u) const {
        const long L = (long)i * G + c; if (L >= nwg) return false;
        int wgid = (int)L; { const int q = nwg / NXCD, r = nwg % NXCD, xcd = wgid % NXCD, off = wgid / NXCD; wgid = (xcd < r ? xcd * (q + 1) : r * (q + 1) + (xcd - r) * q) + off; }
        const int nig = WGM * nN, gid = wgid / nig, fm = gid * WGM, gsz = (nM - fm) < WGM ? (nM - fm) : WGM;
        const int pm = fm + ((wgid % nig) % gsz), pn = (wgid % nig) / gsz;
        if (pn < nsplit) { u.A = A + (size_t)pm * astep; u.B = B + (size_t)pn * bstep; } else { u.A = A2 + (size_t)pm * astep; u.B = B2 + (size_t)(pn - nsplit) * bstep; }
        u.row0 = pm * BM; u.col0 = pn * BM; u.nvalid = BM; u.e = 0; u.lrow0 = 0; u.pad = 0; return true;
    }
};
struct MoeOrder {
    int G, c, NT, total; LAS unsigned* tab; const char* Abase; const char* Bbase; size_t bexp, btile, arow; bool gather;
    __device__ __forceinline__ void init(LAS unsigned* tab_, const unsigned* counts, int NT_, int G_, int c_, const void* A_, const void* B_, size_t bexp_, size_t btile_, size_t arow_, bool gather_) {
        int t_ = threadIdx.x; asm volatile("" : "+v"(t_)); const int lane = t_ & 63;
        G = G_; c = c_; NT = NT_; tab = tab_; Abase = (const char*)A_; Bbase = (const char*)B_; bexp = bexp_; btile = btile_; arow = arow_; gather = gather_;
        const unsigned cnt = (lane < NEXP) ? __hip_atomic_load(counts + lane * CNT_STRIDE, __ATOMIC_RELAXED, __HIP_MEMORY_SCOPE_AGENT) : 0u;
        const unsigned mt = (cnt + 255u) >> 8;
        unsigned incl = mt;
#pragma unroll
        for (int o = 1; o < 64; o <<= 1) { const unsigned t = __shfl_up(incl, o); if (lane >= o) incl += t; }
        const unsigned excl = incl - mt;
        if (t_ < NEXP) { tab[lane] = cnt; tab[32 + lane] = excl * 256u; tab[64 + lane] = excl * (unsigned)NT; }
        total = (int)__builtin_amdgcn_readlane((int)incl, 63) * NT;
        __syncthreads();
    }
    __device__ __forceinline__ bool next(int i, GUnit& u) const {
        long L;
        if ((G & 7) == 0) { const int x = c & 7, q = c >> 3, ux = i * (G >> 3) + q, pl = ux / NT, ntl = ux - pl * NT; const long pair = (long)pl * 8 + x; if (pair * NT >= total) return false; L = pair * NT + ntl; }
        else { L = (long)i * G + c; if (L >= total) return false; }
        int t_ = threadIdx.x; asm volatile("" : "+v"(t_)); const int lane = t_ & 63;
        const unsigned us_l = tab[64 + (lane & 31)];
        const unsigned long long m = __ballot(lane < NEXP && us_l <= (unsigned)L);
        const int e = __builtin_amdgcn_readfirstlane(__popcll(m) - 1);
        const unsigned us = (unsigned)__builtin_amdgcn_readfirstlane((int)tab[64 + e]), ce = (unsigned)__builtin_amdgcn_readfirstlane((int)tab[e]), oe = (unsigned)__builtin_amdgcn_readfirstlane((int)tab[32 + e]);
        const int local = (int)((unsigned)L - us), mt = local / NT, nt = local - mt * NT;
        u.row0 = (int)oe + mt * 256; u.col0 = nt * 256; u.nvalid = (int)ce - mt * 256; if (u.nvalid > 256) u.nvalid = 256; u.e = e; u.lrow0 = e * CAP + mt * 256; u.pad = 0;
        u.A = gather ? Abase : Abase + (size_t)u.row0 * arow;
        u.B = Bbase + (size_t)e * bexp + (size_t)nt * btile;
        return true;
    }
};

template <class Epi, class Sched, bool GATHER, bool ALIGN_EPI, bool FP8 = false>
__device__ __forceinline__ void gemm_phase(LAS unsigned char* lds, const int K, const int lda, const int ldb, const Sched& S, const Epi& E, const unsigned* list) {
    constexpr int ES = FP8 ? 1 : 2;
    int tid_ = threadIdx.x; asm volatile("" : "+v"(tid_));
    const int tid = tid_, wid = __builtin_amdgcn_readfirstlane(tid >> 6), lane = tid & 63, wr = wid >> 2, wc = wid & 3, fr = lane & 15, fq = lane >> 4;
#ifdef PROBE_KDOUBLE
    constexpr bool KD = FP8 && GATHER;
#else
    constexpr bool KD = false;
#endif
    const int nt0 = K * ES / (BK * 2), nt = KD ? 2 * nt0 : nt0;
#ifndef STAGGER_OFF
    { const int q_ = (S.c >> 3) & 31; for (int k_ = 0; k_ < q_; ++k_) __builtin_amdgcn_s_sleep(FP8 ? 2 : 3); }
#endif
    __builtin_amdgcn_s_waitcnt(0x0F70);
#define KW(t_) ((size_t)(KD ? ((t_) & (nt0 - 1)) : (t_)))
    unsigned voffB[2];
#pragma unroll
    for (int i = 0; i < 2; ++i) { int R, C; if constexpr (FP8) { stage_rc8(tid * 16 + i * 8192, R, C); } else { stage_rc(tid * 16 + i * 8192, R, C); C *= 2; }
        const int Rb = Epi::ADJ ? ((R >> 5) * 64 + 16 * ((R & 15) >> 2) + 4 * ((R >> 4) & 1) + (R & 3)) : ((R & ~31) + perm32(R & 31));
        voffB[i] = (unsigned)(Rb * ldb * ES + C); }
    const size_t kstep = (size_t)(BK * 2);
    const size_t hstepB = (size_t)(Epi::ADJ ? 8 : HALF) * ldb * ES;
    const unsigned rowb = (unsigned)lda * (unsigned)ES;
    const unsigned ldsw = (unsigned)wid * 1024u;
    const int aoff = FP8 ? lds_byte8(wr * 64 + fr, fq * 32) : lds_byte(wr * 64 + fr, fq * 8), boff = FP8 ? lds_byte8(wc * 32 + fr, fq * 32) : lds_byte(wc * 32 + fr, fq * 8);
#define PG8_SA(b, h) (((b) * 2 + (h)) * HTB)
#define PG8_SB(b, h) ((4 + (b) * 2 + (h)) * HTB)
#define PG8_GL(bufoff, gptr, i_) __builtin_amdgcn_global_load_lds((const unsigned*)(gptr), (LAS unsigned*)(lds + (bufoff) + ldsw + (i_) * 8192), 16, 0, 0)
#define PG8_OPQ(x) ({ unsigned o_ = (x); asm volatile("" : "+v"(o_)); o_; })
#define PG8_STAGE_B(bufoff, gbase) do { PG8_GL(bufoff, (const char*)(gbase) + PG8_OPQ(voffB[0]), 0); PG8_GL(bufoff, (const char*)(gbase) + PG8_OPQ(voffB[1]), 1); } while (0)
#define PG8_STAGE_A(bufoff, gbase, o0, o1) do { PG8_GL(bufoff, (const char*)(gbase) + PG8_OPQ(o0), 0); PG8_GL(bufoff, (const char*)(gbase) + PG8_OPQ(o1), 1); } while (0)
    constexpr int KOFF = FP8 ? 16 : 1024;
#define aoff1 (FP8 ? (aoff ^ 16) : (aoff + 1024))
#define boff1 (FP8 ? (boff ^ 16) : (boff + 1024))
#define PG8_LD8(addr0, addr1) __builtin_bit_cast(i32x8, __builtin_shufflevector(*(const LAS bf16x8*)(addr0), *(const LAS bf16x8*)(addr1), 0, 1, 2, 3, 4, 5, 6, 7, 8, 9, 10, 11, 12, 13, 14, 15))
#define PG8_LDA(dst, b, h) do { _Pragma("unroll") for (int m = 0; m < 4; ++m) { if constexpr (FP8) dst##8[m] = PG8_LD8(lds + PG8_SA(b, h) + aoff + m * 2048, lds + PG8_SA(b, h) + aoff1 + m * 2048); \
        else { dst[m][0] = *(const LAS bf16x8*)(lds + PG8_SA(b, h) + aoff + m * 2048); dst[m][1] = *(const LAS bf16x8*)(lds + PG8_SA(b, h) + aoff1 + m * 2048); } } } while (0)
#define PG8_LDB(dst, b, h) do { _Pragma("unroll") for (int n = 0; n < 2; ++n) { if constexpr (FP8) dst##8[n] = PG8_LD8(lds + PG8_SB(b, h) + boff + n * 2048, lds + PG8_SB(b, h) + boff1 + n * 2048); \
        else { dst[n][0] = *(const LAS bf16x8*)(lds + PG8_SB(b, h) + boff + n * 2048); dst[n][1] = *(const LAS bf16x8*)(lds + PG8_SB(b, h) + boff1 + n * 2048); } } } while (0)
#define PG8_MMA(ai, bj, At, Bt) do { __builtin_amdgcn_s_setprio(1); _Pragma("unroll") for (int m = 0; m < 4; ++m) _Pragma("unroll") for (int n = 0; n < 2; ++n) { \
        if constexpr (FP8) asm volatile("v_mfma_f32_16x16x128_f8f6f4 %0, %1, %2, %0" : "+v"(acc[ai][bj][m][n]) : "v"(Bt##8[n]), "v"(At##8[m]));     \
        else { _Pragma("unroll") for (int k = 0; k < 2; ++k) acc[ai][bj][m][n] = __builtin_amdgcn_mfma_f32_16x16x32_bf16(Bt[n][k], At[m][k], acc[ai][bj][m][n], 0, 0, 0); } } __builtin_amdgcn_s_setprio(0); } while (0)
#define PG8_WAIT_V(n) asm volatile("s_waitcnt vmcnt(" #n ")" ::: "memory")
#define PG8_WAIT_L(n) asm volatile("s_waitcnt lgkmcnt(" #n ")" ::: "memory")
#define PG8_BAR __builtin_amdgcn_s_barrier()
#define PG8_SCHED __builtin_amdgcn_sched_barrier(0)
#define PG8_AOFFS(dst, u) do { int t2_ = threadIdx.x; asm volatile("" : "+v"(t2_)); unsigned raw_[2][2]; int cb_[2]; \
        _Pragma("unroll") for (int i_ = 0; i_ < 2; ++i_) { int R_, C_; if constexpr (FP8) { stage_rc8(t2_ * 16 + i_ * 8192, R_, C_); C_ >>= 1; } else stage_rc(t2_ * 16 + i_ * 8192, R_, C_); cb_[i_] = C_; \
        _Pragma("unroll") for (int h_ = 0; h_ < 2; ++h_) { const int r_ = h_ * HALF + R_; \
        if constexpr (GATHER) raw_[h_][i_] = list[(u).lrow0 + min(r_, (u).nvalid - 1)]; else raw_[h_][i_] = (unsigned)r_ << 2; } } \
        _Pragma("unroll") for (int i_ = 0; i_ < 2; ++i_) _Pragma("unroll") for (int h_ = 0; h_ < 2; ++h_) dst[h_][i_] = (raw_[h_][i_] >> 2) * rowb + (unsigned)cb_[i_] * 2u; } while (0)
    GUnit cur, nxt; int ui = 0;
    if (!S.next(0, cur)) return;
    f32x4 acc[2][2][4][2];
#pragma unroll
    for (int a = 0; a < 2; ++a)
#pragma unroll
        for (int b = 0; b < 2; ++b)
#pragma unroll
            for (int m = 0; m < 4; ++m)
#pragma unroll
                for (int n = 0; n < 2; ++n) acc[a][b][m][n] = (f32x4){0.f, 0.f, 0.f, 0.f};
    bf16x8 At[4][2], B0[2][2], B1[2][2]; i32x8 At8[4], B08[2], B18[2];
    unsigned cv[2][2], nv[2][2];
    PG8_AOFFS(cv, cur);
    const char* cA = cur.A; const char* cB = cur.B;
    E.prefetch(lds, cur, wid);
    PG8_STAGE_B(PG8_SB(0, 0), cB); PG8_STAGE_B(PG8_SB(0, 1), cB + hstepB); PG8_STAGE_A(PG8_SA(0, 0), cA, cv[0][0], cv[0][1]); PG8_STAGE_A(PG8_SA(0, 1), cA, cv[1][0], cv[1][1]);
    if (wr == 1) PG8_BAR;
    PG8_WAIT_V(2); PG8_BAR;
    PG8_STAGE_B(PG8_SB(1, 0), cB + kstep); PG8_STAGE_A(PG8_SA(1, 0), cA + kstep, cv[0][0], cv[0][1]); PG8_STAGE_B(PG8_SB(1, 1), cB + hstepB + kstep);
    PG8_WAIT_V(6); PG8_BAR;
    for (;;) {
        const bool has_next = S.next(ui + 1, nxt);
        const char* nA = has_next ? nxt.A : cA; const char* nB = has_next ? nxt.B : cB;
        if constexpr (GATHER) {
            int t2_ = threadIdx.x; asm volatile("" : "+v"(t2_));
#pragma unroll
            for (int i_ = 0; i_ < 2; ++i_) { int R_, C_; if constexpr (FP8) { stage_rc8(t2_ * 16 + i_ * 8192, R_, C_); } else stage_rc(t2_ * 16 + i_ * 8192, R_, C_);
#pragma unroll
                for (int h_ = 0; h_ < 2; ++h_) { const int r_ = h_ * HALF + R_; const unsigned* lp_ = list + (has_next ? nxt.lrow0 + min(r_, nxt.nvalid - 1) : cur.lrow0);
                    __builtin_amdgcn_global_load_lds(lp_, (LAS unsigned*)(lds + EPI_LDS_OFF + wid * 2048 + 1024 + (h_ * 2 + i_) * 256), 4, 0, 0); } }
        }
#pragma unroll 1
        for (int t = 0; t < nt; t += 2) {
            const bool last = (t == nt - 2);
            const char* a1 = cA + KW(t + 1) * kstep;
            const char* a2 = last ? nA : cA + KW(t + 2) * kstep; const char* b2 = last ? nB : cB + KW(t + 2) * kstep;
            const char* a3 = a2 + kstep; const char* b3 = b2 + kstep;
            if constexpr (GATHER) { if (last && has_next) { int t4_ = threadIdx.x; asm volatile("" : "+v"(t4_));
#pragma unroll
                for (int i_ = 0; i_ < 2; ++i_) { int R_, C_; if constexpr (FP8) { stage_rc8(t4_ * 16 + i_ * 8192, R_, C_); } else { stage_rc(t4_ * 16 + i_ * 8192, R_, C_); C_ *= 2; }
                    const float w_ = *(const LAS float*)(lds + EPI_LDS_OFF + wid * 2048 + 1024 + i_ * 256 + (t4_ & 63) * 4); cv[0][i_] = (__float_as_uint(w_) >> 2) * rowb + (unsigned)C_; } } }
            PG8_LDB(B0, 0, 0); PG8_LDB(B1, 0, 1); PG8_SCHED; PG8_LDA(At, 0, 0); PG8_STAGE_A(PG8_SA(1, 1), a1, cv[1][0], cv[1][1]);
            if constexpr (GATHER) { if (last && has_next) { int t4_ = threadIdx.x; asm volatile("" : "+v"(t4_));
#pragma unroll
                for (int i_ = 0; i_ < 2; ++i_) { int R_, C_; if constexpr (FP8) { stage_rc8(t4_ * 16 + i_ * 8192, R_, C_); } else { stage_rc(t4_ * 16 + i_ * 8192, R_, C_); C_ *= 2; }
                    const float w_ = *(const LAS float*)(lds + EPI_LDS_OFF + wid * 2048 + 1024 + (2 + i_) * 256 + (t4_ & 63) * 4); cv[1][i_] = (__float_as_uint(w_) >> 2) * rowb + (unsigned)C_; } } }
            PG8_WAIT_V(8); PG8_WAIT_L(0); PG8_BAR; PG8_MMA(0, 0, At, B0); PG8_MMA(0, 1, At, B1); PG8_BAR; PG8_SCHED;
            PG8_LDA(At, 0, 1); PG8_STAGE_B(PG8_SB(0, 0), b2); PG8_STAGE_B(PG8_SB(0, 1), b2 + hstepB); PG8_STAGE_A(PG8_SA(0, 0), a2, cv[0][0], cv[0][1]);
            PG8_WAIT_V(8); PG8_WAIT_L(0); PG8_BAR; PG8_MMA(1, 0, At, B0); PG8_MMA(1, 1, At, B1); PG8_BAR; PG8_SCHED;
            PG8_LDB(B0, 1, 0); PG8_LDB(B1, 1, 1); PG8_SCHED; PG8_LDA(At, 1, 0); PG8_STAGE_A(PG8_SA(0, 1), a2, cv[1][0], cv[1][1]);
            PG8_WAIT_V(8); PG8_WAIT_L(0); PG8_BAR; PG8_MMA(0, 0, At, B0); PG8_MMA(0, 1, At, B1); PG8_BAR; PG8_SCHED;
            PG8_LDA(At, 1, 1); PG8_STAGE_B(PG8_SB(1, 0), b3); PG8_STAGE_B(PG8_SB(1, 1), b3 + hstepB); PG8_STAGE_A(PG8_SA(1, 0), a3, cv[0][0], cv[0][1]);
            PG8_WAIT_V(8); PG8_WAIT_L(0); PG8_BAR; PG8_MMA(1, 0, At, B0); PG8_MMA(1, 1, At, B1); PG8_BAR; PG8_SCHED;
        }
        if constexpr (ALIGN_EPI) { if (wr == 0) PG8_BAR; }
        if constexpr (FP8) asm volatile("s_nop 15\n\ts_nop 7" ::: "memory");
        { int t3_ = threadIdx.x; asm volatile("" : "+v"(t3_)); E(acc, cur, wr, wc, t3_ & 15, (t3_ >> 4) & 3, lds, wid); }
        if (!has_next) break;
#pragma unroll
        for (int a = 0; a < 2; ++a)
#pragma unroll
            for (int b = 0; b < 2; ++b)
#pragma unroll
                for (int m = 0; m < 4; ++m)
#pragma unroll
                    for (int n = 0; n < 2; ++n) acc[a][b][m][n] = (f32x4){0.f, 0.f, 0.f, 0.f};
        cur = nxt; cA = nA; cB = nB; ++ui;
        E.prefetch(lds, cur, wid);
        if constexpr (ALIGN_EPI) { if (wr == 1) PG8_BAR; }
    }
    PG8_WAIT_V(0);
    if constexpr (!ALIGN_EPI) { if (wr == 0) PG8_BAR; }
    PG8_BAR;
#undef PG8_SA
#undef PG8_SB
#undef PG8_GL
#undef PG8_STAGE_A
#undef PG8_OPQ
#undef PG8_STAGE_B
#undef PG8_LDA
#undef PG8_LDB
#undef PG8_MMA
#undef PG8_LD8
#undef aoff1
#undef boff1
#undef PG8_WAIT_V
#undef PG8_WAIT_L
#undef PG8_BAR
#undef PG8_SCHED
#undef PG8_AOFFS
#undef KW
}
}

namespace pg8 {
typedef const f32x4 (&AccRef)[2][2][4][2];
__device__ __forceinline__ void st_pair_rows(bf16* rowp, int ld, int fr, u32x4 A, u32x4 B) {
    const bool lo = fr < 8;
    const u32x4 send = lo ? B : A; u32x4 recv;
    recv.x = (unsigned)__builtin_amdgcn_update_dpp(0, (int)send.x, 0x128, 0xF, 0xF, true); recv.y = (unsigned)__builtin_amdgcn_update_dpp(0, (int)send.y, 0x128, 0xF, 0xF, true);
    recv.z = (unsigned)__builtin_amdgcn_update_dpp(0, (int)send.z, 0x128, 0xF, 0xF, true); recv.w = (unsigned)__builtin_amdgcn_update_dpp(0, (int)send.w, 0x128, 0xF, 0xF, true);
    bf16* p1 = rowp + (lo ? 0 : 8 - 8 * ld);
    *(u32x4*)p1 = lo ? A : recv;
    *(u32x4*)(p1 + 8 * ld) = lo ? recv : B;
}
__device__ __forceinline__ u32x4 pack8(f32x4 v0, f32x4 v1) { u32x4 w; w.x = cvt_pk_bf16(v0[0], v0[1]); w.y = cvt_pk_bf16(v0[2], v0[3]); w.z = cvt_pk_bf16(v1[0], v1[1]); w.w = cvt_pk_bf16(v1[2], v1[3]); return w; }
struct EpiProjEven {
    static constexpr bool ADJ = true;
    bf16* O;
    __device__ __forceinline__ void prefetch(LAS unsigned char*, const GUnit&, int) const {}
    __device__ __forceinline__ void operator()(AccRef acc, const GUnit& u, int wr, int wc, int fr, int fq, LAS unsigned char* lds, int wid) const {
        const int row0 = u.row0 + wr * 64 + fr, col = u.col0 + wc * 64 + 16 * fq; const bool act = u.col0 >= 1536;
#pragma unroll
        for (int ai = 0; ai < 2; ++ai)
#pragma unroll
            for (int m = 0; m < 4; ++m) { bf16* rowp = O + (size_t)(row0 + ai * HALF + m * 16) * EVEN_IN + col; u32x4 pk2[2];
#pragma unroll
                for (int bj = 0; bj < 2; ++bj) { f32x4 v0 = acc[ai][bj][m][0], v1 = acc[ai][bj][m][1];
                    if (act) {
                        constexpr float C1 = -2.0f * LOG2E * 0.7978845608028654f, C2 = C1 * 0.044715f;
#pragma unroll
                        for (int hv = 0; hv < 2; ++hv)
#pragma unroll
                            for (int jp = 0; jp < 2; ++jp) { const f32x4 vv = hv ? v1 : v0; const f32x2 x = (f32x2){vv[2 * jp], vv[2 * jp + 1]};
                                f32x2 a = __builtin_elementwise_fma(x * x, (f32x2){C2, C2}, (f32x2){C1, C1}) * x; a.x = __builtin_amdgcn_exp2f(a.x); a.y = __builtin_amdgcn_exp2f(a.y);
                                f32x2 d = a + 1.0f; d.x = __builtin_amdgcn_rcpf(d.x); d.y = __builtin_amdgcn_rcpf(d.y); const f32x2 r = x * d;
                                if (hv) { v1[2 * jp] = r.x; v1[2 * jp + 1] = r.y; } else { v0[2 * jp] = r.x; v0[2 * jp + 1] = r.y; } } }
                    pk2[bj] = pack8(v0, v1); }
                st_pair_rows(rowp, EVEN_IN, fr, pk2[0], pk2[1]); }
    }
};
struct EpiProjOdd {
    static constexpr bool ADJ = true;
    bf16* O; float* fz;
    __device__ __forceinline__ void prefetch(LAS unsigned char*, const GUnit&, int) const {}
    __device__ __forceinline__ void operator()(AccRef acc, const GUnit& u, int wr, int wc, int fr, int fq, LAS unsigned char* lds, int wid) const {
        const int row0 = u.row0 + wr * 64 + fr, col = u.col0 + wc * 64 + 16 * fq; const bool zt = (u.col0 == 1792) && (wc == 2) && (fq == 2);
#pragma unroll
        for (int ai = 0; ai < 2; ++ai)
#pragma unroll
            for (int m = 0; m < 4; ++m) { const int row = row0 + ai * HALF + m * 16; bf16* rowp = O + (size_t)row * ODD_LD + col;
                st_pair_rows(rowp, ODD_LD, fr, pack8(acc[ai][0][m][0], acc[ai][0][m][1]), pack8(acc[ai][1][m][0], acc[ai][1][m][1]));
                if (zt) { *(f32x4*)(fz + (size_t)row * 8) = acc[ai][0][m][0]; *(f32x4*)(fz + (size_t)row * 8 + 4) = acc[ai][0][m][1]; } }
    }
};
struct EpiQKV {
    static constexpr bool ADJ = true;
    bf16* Q; bf16* KV; const float* cosT; const float* sinT;
    __device__ __forceinline__ void prefetch(LAS unsigned char*, const GUnit&, int) const {}
    __device__ __forceinline__ void operator()(AccRef acc, const GUnit& u, int wr, int wc, int fr, int fq, LAS unsigned char* lds, int wid) const {
        const int row0 = u.row0 + wr * 64 + fr;
        if (u.col0 < 768) {
            const int col = u.col0 + wc * 64 + 16 * fq;
            bool rp[2]; int i0[2];
#pragma unroll
            for (int bj = 0; bj < 2; ++bj) { const int d = (col + 8 * bj) % 96; rp[bj] = d >= 64; i0[bj] = rp[bj] ? ((d - 64) >> 1) : 0; }
#pragma unroll
            for (int ai = 0; ai < 2; ++ai)
#pragma unroll
                for (int mh = 0; mh < 2; ++mh) {
                    f32x4 cc[2][2], ss[2][2];
#pragma unroll
                    for (int mm = 0; mm < 2; ++mm) { const int pos = (row0 + ai * HALF + (2 * mh + mm) * 16) & (SEQ - 1);
#pragma unroll
                        for (int bj = 0; bj < 2; ++bj) { cc[mm][bj] = *(const f32x4*)(cosT + pos * 16 + i0[bj]); ss[mm][bj] = *(const f32x4*)(sinT + pos * 16 + i0[bj]); } }
#pragma unroll
                    for (int mm = 0; mm < 2; ++mm) { const int m = 2 * mh + mm; const int row = row0 + ai * HALF + m * 16; u32x4 pk2[2];
#pragma unroll
                        for (int bj = 0; bj < 2; ++bj) { f32x4 v0 = acc[ai][bj][m][0], v1 = acc[ai][bj][m][1];
                            f32x4 c = cc[mm][bj], sn = ss[mm][bj]; const f32x4 a0 = v0, a1 = v1;
#pragma unroll
                            for (int j = 0; j < 4; ++j) { c[j] = rp[bj] ? c[j] : 1.0f; sn[j] = rp[bj] ? sn[j] : 0.0f; }
                            v0[0] = a0[0] * c[0] - a0[1] * sn[0]; v0[1] = a0[1] * c[0] + a0[0] * sn[0]; v0[2] = a0[2] * c[1] - a0[3] * sn[1]; v0[3] = a0[3] * c[1] + a0[2] * sn[1];
                            v1[0] = a1[0] * c[2] - a1[1] * sn[2]; v1[1] = a1[1] * c[2] + a1[0] * sn[2]; v1[2] = a1[2] * c[3] - a1[3] * sn[3]; v1[3] = a1[3] * c[3] + a1[2] * sn[3];
                            pk2[bj] = pack8(v0, v1); }
                        st_pair_rows(Q + (size_t)row * 768 + col, 768, fr, pk2[0], pk2[1]); } }
        } else {
            const int col = u.col0 - 768 + wc * 64 + 16 * fq;
#pragma unroll
            for (int ai = 0; ai < 2; ++ai)
#pragma unroll
                for (int m = 0; m < 4; ++m) { bf16* rowp = KV + (size_t)(row0 + ai * HALF + m * 16) * 1024 + col;
                    st_pair_rows(rowp, 1024, fr, pack8(acc[ai][0][m][0], acc[ai][0][m][1]), pack8(acc[ai][1][m][0], acc[ai][1][m][1])); }
        }
    }
};
struct EpiOutProj {
    static constexpr bool ADJ = true;
    bf16* P;
    __device__ __forceinline__ void prefetch(LAS unsigned char*, const GUnit&, int) const {}
    __device__ __forceinline__ void operator()(AccRef acc, const GUnit& u, int wr, int wc, int fr, int fq, LAS unsigned char* lds, int wid) const {
        const int row0 = u.row0 + wr * 64 + fr, col = u.col0 + wc * 64 + 16 * fq;
#pragma unroll
        for (int ai = 0; ai < 2; ++ai)
#pragma unroll
            for (int m = 0; m < 4; ++m) { bf16* rowp = P + (size_t)(row0 + ai * HALF + m * 16) * DM + col;
                st_pair_rows(rowp, DM, fr, pack8(acc[ai][0][m][0], acc[ai][0][m][1]), pack8(acc[ai][1][m][0], acc[ai][1][m][1])); }
    }
};
#ifdef PROBE_KDOUBLE
constexpr float W8_SCALE = 64.0f, W8_INV = 1.0f / 64.0f, W8_INV1 = 0.5f / 64.0f;
#else
constexpr float W8_SCALE = 64.0f, W8_INV = 1.0f / 64.0f, W8_INV1 = W8_INV;
#endif
__device__ __forceinline__ unsigned pk_fp8x4(float a, float b, float c, float d) { unsigned w = 0u; w = (unsigned)__builtin_amdgcn_cvt_pk_fp8_f32(a, b, (int)w, false); w = (unsigned)__builtin_amdgcn_cvt_pk_fp8_f32(c, d, (int)w, true); return w; }
struct EpiSwiGLU {
    static constexpr bool ADJ = false;
    unsigned char* H; const float* b1p;
    __device__ __forceinline__ void prefetch(LAS unsigned char* lds, const GUnit& u, int wid) const {
        int l_ = threadIdx.x; asm volatile("" : "+v"(l_)); l_ &= 63;
        __builtin_amdgcn_global_load_lds((const unsigned*)(b1p + (size_t)u.e * 2048 + u.col0 + l_ * 4), (LAS unsigned*)(lds + EPI_LDS_OFF + wid * 2048), 16, 0, 0); }
    __device__ __forceinline__ void operator()(AccRef acc, const GUnit& u, int wr, int wc, int fr, int fq, LAS unsigned char* lds, int wid) const {
        const int cl = wc * 32 + 8 * fq; const LAS float* bp = (const LAS float*)(lds + EPI_LDS_OFF + wid * 2048) + cl;
        f32x4 bg0 = *(const LAS f32x4*)bp, bg1 = *(const LAS f32x4*)(bp + 4), bl0 = *(const LAS f32x4*)(bp + HALF), bl1 = *(const LAS f32x4*)(bp + HALF + 4);
        const int ocol = (u.col0 >> 1) + cl;
        bl0 = bl0 + 1.0f; bl1 = bl1 + 1.0f;
#pragma unroll
        for (int ai = 0; ai < 2; ++ai)
#pragma unroll
            for (int m = 0; m < 4; ++m) { const int rl = ai * HALF + wr * 64 + m * 16 + fr;
                f32x4 o[2];
#pragma unroll
                for (int n = 0; n < 2; ++n) { const f32x4 ag = acc[ai][0][m][n], al = acc[ai][1][m][n], bg = n ? bg1 : bg0, bl = n ? bl1 : bl0;
#pragma unroll
                    for (int jp = 0; jp < 2; ++jp) {
                        f32x2 g2 = __builtin_elementwise_fma((f32x2){ag[2 * jp], ag[2 * jp + 1]}, (f32x2){W8_INV1, W8_INV1}, (f32x2){bg[2 * jp], bg[2 * jp + 1]});
                        f32x2 l2 = __builtin_elementwise_fma((f32x2){al[2 * jp], al[2 * jp + 1]}, (f32x2){W8_INV1, W8_INV1}, (f32x2){bl[2 * jp], bl[2 * jp + 1]});
                        g2.x = fminf(g2.x, 7.0f); g2.y = fminf(g2.y, 7.0f);
                        l2.x = __builtin_amdgcn_fmed3f(l2.x, -6.0f, 8.0f); l2.y = __builtin_amdgcn_fmed3f(l2.y, -6.0f, 8.0f);
                        f32x2 e2 = g2 * (-1.702f * LOG2E); e2.x = __builtin_amdgcn_exp2f(e2.x); e2.y = __builtin_amdgcn_exp2f(e2.y);
                        f32x2 d2 = e2 + 1.0f; d2.x = __builtin_amdgcn_rcpf(d2.x); d2.y = __builtin_amdgcn_rcpf(d2.y);
                        const f32x2 r2 = (g2 * d2) * l2;
                        o[n][2 * jp] = r2.x; o[n][2 * jp + 1] = r2.y; } }
                if (rl < u.nvalid) { u32x2 w; w.x = pk_fp8x4(o[0][0], o[0][1], o[0][2], o[0][3]); w.y = pk_fp8x4(o[1][0], o[1][1], o[1][2], o[1][3]); *(u32x2*)(H + (size_t)(u.row0 + rl) * DFF + ocol) = w; } }
    }
};
struct EpiMoeOut {
    static constexpr bool ADJ = true;
    unsigned char* O2; const float* b2; const float* glist;
    __device__ __forceinline__ void prefetch(LAS unsigned char* lds, const GUnit& u, int wid) const {
        int l_ = threadIdx.x; asm volatile("" : "+v"(l_)); l_ &= 63;
        __builtin_amdgcn_global_load_lds((const unsigned*)(b2 + (size_t)u.e * DM + u.col0 + l_ * 4), (LAS unsigned*)(lds + EPI_LDS_OFF + wid * 2048), 16, 0, 0);
        __builtin_amdgcn_global_load_lds((const unsigned*)(glist + u.lrow0 + l_ * 4), (LAS unsigned*)(lds + EPI_LDS_OFF + wid * 2048 + 1024), 16, 0, 0); }
    __device__ __forceinline__ void operator()(AccRef acc, const GUnit& u, int wr, int wc, int fr, int fq, LAS unsigned char* lds, int wid) const {
        const int col = u.col0 + wc * 64 + 16 * fq;
        const LAS float* bp = (const LAS float*)(lds + EPI_LDS_OFF + wid * 2048) + wc * 64 + 16 * fq; const LAS float* gp = (const LAS float*)(lds + EPI_LDS_OFF + wid * 2048 + 1024);
        float gv[2][4]; f32x4 bv[2][2];
#pragma unroll
        for (int ai = 0; ai < 2; ++ai)
#pragma unroll
            for (int m = 0; m < 4; ++m) gv[ai][m] = gp[ai * HALF + wr * 64 + m * 16 + fr];
#pragma unroll
        for (int bj = 0; bj < 2; ++bj) { bv[bj][0] = *(const LAS f32x4*)(bp + bj * 8); bv[bj][1] = *(const LAS f32x4*)(bp + bj * 8 + 4); }
        unsigned char* base = O2 + (size_t)(u.row0 + wr * 64 + fr) * DM + col;
#pragma unroll
        for (int ai = 0; ai < 2; ++ai)
#pragma unroll
            for (int m = 0; m < 4; ++m) { const int rl = ai * HALF + wr * 64 + m * 16 + fr; const bool ok = rl < u.nvalid; const float g = gv[ai][m];
                u32x2 w[2];
#pragma unroll
                for (int bj = 0; bj < 2; ++bj) { const f32x4 v0 = (acc[ai][bj][m][0] * W8_INV + bv[bj][0]) * g, v1 = (acc[ai][bj][m][1] * W8_INV + bv[bj][1]) * g; w[bj].x = pk_fp8x4(v0[0], v0[1], v0[2], v0[3]); w[bj].y = pk_fp8x4(v1[0], v1[1], v1[2], v1[3]); }
                if (ok) { unsigned char* rowp = base + (size_t)(ai * HALF + m * 16) * DM; *(u32x4*)rowp = (u32x4){w[0].x, w[0].y, w[1].x, w[1].y}; } }
    }
};
}

__device__ const float ROPE_INVF[16] = {1.0f, 0.5623413251903491f, 0.31622776601683794f, 0.1778279410038923f, 0.1f, 0.05623413251903491f, 0.03162277660168379f, 0.01778279410038923f,
                                        0.01f, 0.005623413251903491f, 0.0031622776601683794f, 0.0017782794100389228f, 0.001f, 0.0005623413251903491f, 0.00031622776601683794f, 0.00017782794100389227f};
template <int MODE, bool OUT8 = false>
__device__ __forceinline__ void tr_item(const float* W, int N, int Nvalid, int k0, int c0, bf16* dst, int ldd, LAS float* scr, int lane, const float* aux) {
    (void)scr;
    const int c = c0 + lane; const bool cok = c < Nvalid; const int cr = cok ? c : Nvalid - 1;
    float cs = cok ? 1.0f : 0.0f; if (MODE == 1) cs = (c >= 416 && c < 928) ? FOX_QS : cs; if (OUT8) cs *= pg8::W8_SCALE;
    const float* wp = W + (size_t)k0 * N + cr;
    int dr = c;
    if (MODE == 2) { const int h = c / 96, d = c - h * 96; if (d >= 64) dr = h * 96 + 64 + 2 * ((d - 64) & 15) + ((d - 64) >> 4); }
    if (MODE == 4) { const int j = c >> 1, half = c & 1; dr = (j >> 7) * 256 + half * 128 + (j & 127); }
    float t[64];
#pragma unroll
    for (int i = 0; i < 64; ++i) t[i] = wp[(size_t)i * N];
#pragma unroll
    for (int i = 0; i < 64; ++i) { t[i] *= cs; if (MODE == 2) t[i] *= aux[k0 + i] * MLA_QS; if (MODE == 3) t[i] *= aux[k0 + i]; }
    if (OUT8) { unsigned char* dp = (unsigned char*)dst + (size_t)dr * ldd + k0;
#pragma unroll
        for (int q = 0; q < 4; ++q) { u32x4 o; o.x = pg8::pk_fp8x4(t[16 * q], t[16 * q + 1], t[16 * q + 2], t[16 * q + 3]); o.y = pg8::pk_fp8x4(t[16 * q + 4], t[16 * q + 5], t[16 * q + 6], t[16 * q + 7]);
            o.z = pg8::pk_fp8x4(t[16 * q + 8], t[16 * q + 9], t[16 * q + 10], t[16 * q + 11]); o.w = pg8::pk_fp8x4(t[16 * q + 12], t[16 * q + 13], t[16 * q + 14], t[16 * q + 15]); *(u32x4*)(dp + 16 * q) = o; } }
    else { bf16* dp = dst + (size_t)dr * ldd + k0;
#pragma unroll
        for (int q = 0; q < 8; ++q) { u32x4 o; o.x = cvt_pk_bf16(t[8 * q], t[8 * q + 1]); o.y = cvt_pk_bf16(t[8 * q + 2], t[8 * q + 3]); o.z = cvt_pk_bf16(t[8 * q + 4], t[8 * q + 5]); o.w = cvt_pk_bf16(t[8 * q + 6], t[8 * q + 7]); *(u32x4*)(dp + 8 * q) = o; } }
}

template <int MODE>
__device__ __forceinline__ void tr_block256(const float* W, int N, int k0, int c0, unsigned char* dst, int lane, LAS unsigned char* xs) {
    const int c = c0 + 4 * lane;
    const f32x4* wp = (const f32x4*)(W + (size_t)k0 * N + c);
    unsigned pk[4][32];
#pragma unroll
    for (int kk = 0; kk < 8; ++kk) {
        f32x4 t[16];
#pragma unroll
        for (int i = 0; i < 16; ++i) t[i] = __builtin_nontemporal_load(wp + (size_t)(16 * kk + i) * (N / 4));
#pragma unroll
        for (int j = 0; j < 4; ++j)
#pragma unroll
            for (int q = 0; q < 4; ++q) pk[j][4 * kk + q] = pg8::pk_fp8x4(t[4 * q][j] * pg8::W8_SCALE, t[4 * q + 1][j] * pg8::W8_SCALE, t[4 * q + 2][j] * pg8::W8_SCALE, t[4 * q + 3][j] * pg8::W8_SCALE);
    }
#pragma unroll
    for (int j = 0; j < 4; ++j) {
#pragma unroll
        for (int q = 0; q < 8; ++q) *(LAS u32x4*)(xs + lane * 144 + 16 * q) = (u32x4){pk[j][4 * q], pk[j][4 * q + 1], pk[j][4 * q + 2], pk[j][4 * q + 3]};
#pragma unroll
        for (int r = 0; r < 8; ++r) { const int sl = 8 * r + (lane >> 3);
            const u32x4 v = *(const LAS u32x4*)(xs + sl * 144 + 16 * (lane & 7));
            const int cc = c0 + 4 * sl + j; int dr = cc;
            if (MODE == 4) { const int jj = cc >> 1, half = cc & 1; dr = (jj >> 7) * 256 + half * 128 + (jj & 127); }
            *(u32x4*)(dst + (size_t)dr * 1024 + k0 + 16 * (lane & 7)) = v; }
    }
}

struct Args { const float* in[25]; float* out; unsigned char* ws; int ph_lo, ph_hi; };

__device__ __forceinline__ void prologue_phase(const Args& a, LAS unsigned char* lds, int G, int c) {
    int tid_ = threadIdx.x; asm volatile("" : "+v"(tid_));
    const int tid = tid_, lane = tid & 63, wid = __builtin_amdgcn_readfirstlane(tid >> 6);
    LAS float* scr = (LAS float*)(lds + wid * 16640);
    unsigned char* ws = a.ws;
    const int gw = c * 8 + wid, NGW = G * 8;
    constexpr int I_W1 = 128 * 8 * 8, I_W2 = 128 * 8 * 4,         I_EVIN = 2 * 16 * 40, I_EVOUT = 2 * 16 * 16, I_ODIN = 2 * 16 * 32, I_ODOUT = 2 * 16 * 16, I_UQ = 2 * 4 * 12, I_UKV = 2 * 2 * 16;
    constexpr int TOTAL = I_W1 + I_W2 + I_EVIN + I_EVOUT + I_ODIN + I_ODOUT + I_UQ + I_UKV;
    for (int it = gw; it < TOTAL; it += NGW) {
        int r = it;
        if (r < I_W1) { const int mat = r >> 6, kp = (r >> 3) & 7, cb = r & 7;
            tr_block256<4>(a.in[21] + (size_t)mat * 1024 * 2048, 2048, kp * 128, cb * 256, ws + WS_W1T + (size_t)mat * 2048 * 1024, lane, (LAS unsigned char*)scr); continue; } r -= I_W1;
        if (r < I_W2) { const int mat = r >> 5, kp = (r >> 2) & 7, cb = r & 3;
            tr_block256<0>(a.in[23] + (size_t)mat * 1024 * 1024, 1024, kp * 128, cb * 256, ws + WS_W2T + (size_t)mat * 1024 * 1024, lane, (LAS unsigned char*)scr); continue; } r -= I_W2;
        if (r < I_EVIN) { const int mat = r / 640, q = r % 640, kb = q / 40, cb = q % 40;
            tr_item<0>(a.in[1] + (size_t)mat * 1024 * EVEN_IN, EVEN_IN, EVEN_IN, kb * 64, cb * 64, (bf16*)(ws + WS_EVIN) + (size_t)mat * EVEN_IN * 1024, 1024, scr, lane, nullptr); continue; } r -= I_EVIN;
        if (r < I_EVOUT) { const int mat = r >> 8, kb = (r >> 4) & 15, cb = r & 15;
            tr_item<0>(a.in[7] + (size_t)mat * 1024 * 1024, 1024, 1024, kb * 64, cb * 64, (bf16*)(ws + WS_EVOUT) + (size_t)mat * 1024 * 1024, 1024, scr, lane, nullptr); continue; } r -= I_EVOUT;
        if (r < I_ODIN) { const int mat = r >> 9, kb = (r >> 5) & 15, cb = r & 31;
            tr_item<1>(a.in[8] + (size_t)mat * 1024 * ODD_IN, ODD_IN, ODD_IN, kb * 64, cb * 64, (bf16*)(ws + WS_ODIN) + (size_t)mat * ODD_INP * 1024, 1024, scr, lane, nullptr); continue; } r -= I_ODIN;
        if (r < I_ODOUT) { const int mat = r >> 8, kb = (r >> 4) & 15, cb = r & 15;
            tr_item<0>(a.in[14] + (size_t)mat * 1024 * 1024, 1024, 1024, kb * 64, cb * 64, (bf16*)(ws + WS_ODOUT) + (size_t)mat * 1024 * 1024, 1024, scr, lane, nullptr); continue; } r -= I_ODOUT;
        if (r < I_UQ) { const int mat = r / 48, q = r % 48, kb = q / 12, cb = q % 12;
            tr_item<2>(a.in[11] + (size_t)mat * 256 * 768, 768, 768, kb * 64, cb * 64, (bf16*)(ws + WS_UQT) + (size_t)mat * 768 * 256, 256, scr, lane, a.in[9] + mat * 256); continue; } r -= I_UQ;
        { const int mat = r >> 5, kb = (r >> 4) & 1, cb = r & 15;
            tr_item<3>(a.in[12] + (size_t)mat * 128 * 1024, 1024, 1024, kb * 64, cb * 64, (bf16*)(ws + WS_UKVT) + (size_t)mat * 1024 * 256, 256, scr, lane, a.in[10] + mat * 128); }
    }
    const size_t gt = (size_t)c * 512 + tid, NGT = (size_t)G * 512;
    { const f32x4* x4 = (const f32x4*)a.in[0]; u32x2* xb = (u32x2*)(ws + WS_XB);
      static_assert(((size_t)NTOK * DM / 4) % (4 * 256 * 512) == 0, "x conversion: four float4 per thread per trip on the 256 x 512 grid");
      for (size_t i = gt; i + 3 * NGT < (size_t)NTOK * DM / 4; i += 4 * NGT) { f32x4 v[4];
#pragma unroll
          for (int q = 0; q < 4; ++q) v[q] = x4[i + q * NGT];
#pragma unroll
          for (int q = 0; q < 4; ++q) { u32x2 o; o.x = cvt_pk_bf16(v[q][0], v[q][1]); o.y = cvt_pk_bf16(v[q][2], v[q][3]); xb[i + q * NGT] = o; } } }
    { float* cosT = (float*)(ws + WS_ROPE); float* sinT = cosT + SEQ * 16;
      for (size_t i = gt; i < (size_t)SEQ * 16; i += NGT) { const int pos = (int)(i >> 4), k = (int)(i & 15);
          double r = (double)pos * (double)ROPE_INVF[k] * 0.15915494309189535; r -= floor(r); const float fr = (float)r;
          cosT[i] = __builtin_amdgcn_cosf(fr); sinT[i] = __builtin_amdgcn_sinf(fr); } }
    { bf16* wrt = (bf16*)(ws + WS_WRT); const float* wr = a.in[19];
      for (size_t i = gt; i < (size_t)DEPTH * NEXP * DM; i += NGT) { const int l = (int)(i >> 15), e = (int)(i >> 10) & 31, k = (int)(i & 1023); const float w = wr[((size_t)l * DM + k) * NEXP + e];
          const unsigned hi = f2bf(w), lo = f2bf(w - bf2f(hi)); const size_t d = ((size_t)l * 2 * NEXP + e) * DM + (size_t)(((k >> 3) ^ (e & 15)) * 8 + (k & 7));
          wrt[d] = (bf16)hi; wrt[d + (size_t)NEXP * DM] = (bf16)lo; } }
    { float* b1p = (float*)(ws + WS_B1P); const float* b1 = a.in[22];
      for (size_t i = gt; i < (size_t)DEPTH * NEXP * 2048; i += NGT) { const int np = (int)(i & 2047), pn = np >> 8, half = (np >> 7) & 1, cc = np & 127; b1p[i] = b1[(i & ~(size_t)2047) + 2 * (128 * pn + cc) + half]; } }
    { bf16* sw = (bf16*)(ws + WS_SGUW); const float* s = a.in[5];
      for (size_t i = gt; i < (size_t)2 * 8 * 128 * 128; i += NGT) { const int ii = (int)(i >> 7) & 127, jj = (int)(i & 127); sw[i] = ((jj >> 6) <= (ii >> 6)) ? (bf16)f2bf(s[i]) : (bf16)0; } }
    { bf16* uk = (bf16*)(ws + WS_UKVT);
      for (size_t i = gt; i < (size_t)2 * 1024 * 128; i += NGT) { const size_t row = i >> 7; uk[row * 256 + 128 + (i & 127)] = 0; } }
}

__device__ __forceinline__ void sgu_phase(LAS unsigned char* lds, const bf16* proj, bf16* y, const bf16* sguw, const float* ln_g, const float* ln_b, const float* sgu_b, const float* conv_w, int G, int c) {
    int tid_ = threadIdx.x; asm volatile("" : "+v"(tid_));
    const int tid = tid_, lane = tid & 63, wid = __builtin_amdgcn_readfirstlane(tid >> 6);
    constexpr int VST = 144;
    for (int unit = c; unit < 2048; unit += G) {
        const int blk = unit >> 3, g = unit & 7;
        const int j = tid >> 2, part = tid & 3;
        const size_t tok = (size_t)blk * 128 + j;
        bf16x8 wfr[4];
        { const bf16* wp0 = sguw + ((size_t)g * 128 + 16 * wid + (lane & 15)) * 128 + 8 * (lane >> 4);
#pragma unroll
          for (int ks = 0; ks < 4; ++ks) wfr[ks] = *(const bf16x8*)(wp0 + 32 * ks); }
        {
            const bf16* vp = proj + tok * EVEN_IN + 2048 + g * 64 + part * 16;
            const u32x4 r0 = *(const u32x4*)vp, r1 = *(const u32x4*)(vp + 8);
            float v[16];
            v[0] = bf2f(r0.x & 0xffffu); v[1] = bf2f(r0.x >> 16); v[2] = bf2f(r0.y & 0xffffu); v[3] = bf2f(r0.y >> 16); v[4] = bf2f(r0.z & 0xffffu); v[5] = bf2f(r0.z >> 16); v[6] = bf2f(r0.w & 0xffffu); v[7] = bf2f(r0.w >> 16);
            v[8] = bf2f(r1.x & 0xffffu); v[9] = bf2f(r1.x >> 16); v[10] = bf2f(r1.y & 0xffffu); v[11] = bf2f(r1.y >> 16); v[12] = bf2f(r1.z & 0xffffu); v[13] = bf2f(r1.z >> 16); v[14] = bf2f(r1.w & 0xffffu); v[15] = bf2f(r1.w >> 16);
            float s = 0.f;
#pragma unroll
            for (int i = 0; i < 16; ++i) s += v[i];
            s += __shfl_xor(s, 1); s += __shfl_xor(s, 2);
            const float mean = s * (1.0f / 64.0f); float q = 0.f;
#pragma unroll
            for (int i = 0; i < 16; ++i) { v[i] -= mean; q += v[i] * v[i]; }
            q += __shfl_xor(q, 1); q += __shfl_xor(q, 2);
            const float rstd = 1.0f / sqrtf(q * (1.0f / 64.0f) + LN_EPS);
            const float* gp = ln_g + g * 64 + part * 16; const float* bp = ln_b + g * 64 + part * 16;
            unsigned o[8];
#pragma unroll
            for (int i = 0; i < 16; i += 4) { const f32x4 g4 = *(const f32x4*)(gp + i), b4 = *(const f32x4*)(bp + i);
                o[i / 2] = cvt_pk_bf16(v[i] * rstd * g4[0] + b4[0], v[i + 1] * rstd * g4[1] + b4[1]); o[i / 2 + 1] = cvt_pk_bf16(v[i + 2] * rstd * g4[2] + b4[2], v[i + 3] * rstd * g4[3] + b4[3]); }
            LAS u32x4* dp = (LAS u32x4*)(lds + j * VST + part * 32);
            dp[0] = (u32x4){o[0], o[1], o[2], o[3]}; dp[1] = (u32x4){o[4], o[5], o[6], o[7]};
        }
        {
            const int pos = (int)(tok & (SEQ - 1)); const int ch0 = g * 64 + part * 16;
            const bf16* p0 = proj + tok * EVEN_IN + ch0;
            const float m1 = pos >= 1 ? 1.0f : 0.0f, m2 = pos >= 2 ? 1.0f : 0.0f;
            const int o1 = pos >= 1 ? EVEN_IN : 0, o2 = pos >= 2 ? 2 * EVEN_IN : 0;
            u32x4 c0[2], v0[2], b0[2], c1[2], v1[2], c2[2], v2[2]; f32x4 wt[3][2][2];
#pragma unroll
            for (int hf = 0; hf < 2; ++hf) { const bf16* p = p0 + hf * 8;
                c0[hf] = *(const u32x4*)p; v0[hf] = *(const u32x4*)(p + 1024); b0[hf] = *(const u32x4*)(p + 512);
                c1[hf] = *(const u32x4*)(p - o1); v1[hf] = *(const u32x4*)(p - o1 + 1024); c2[hf] = *(const u32x4*)(p - o2); v2[hf] = *(const u32x4*)(p - o2 + 1024);
#pragma unroll
                for (int tp = 0; tp < 3; ++tp) { wt[tp][hf][0] = *(const f32x4*)(conv_w + tp * 512 + ch0 + hf * 8); wt[tp][hf][1] = *(const f32x4*)(conv_w + tp * 512 + ch0 + hf * 8 + 4); } }
            u32x4 oh[2];
#pragma unroll
            for (int hf = 0; hf < 2; ++hf) {
                unsigned o[4];
#pragma unroll
                for (int k = 0; k < 4; ++k) {
                    const float w0a = wt[0][hf][k >> 1][(k & 1) * 2] * m2, w0b = wt[0][hf][k >> 1][(k & 1) * 2 + 1] * m2, w1a = wt[1][hf][k >> 1][(k & 1) * 2] * m1, w1b = wt[1][hf][k >> 1][(k & 1) * 2 + 1] * m1;
                    const float w2a = wt[2][hf][k >> 1][(k & 1) * 2], w2b = wt[2][hf][k >> 1][(k & 1) * 2 + 1];
                    const float h0a = bf2f(c0[hf][k] & 0xffffu) * bf2f(v0[hf][k] & 0xffffu), h0b = bf2f(c0[hf][k] >> 16) * bf2f(v0[hf][k] >> 16);
                    const float h1a = bf2f(c1[hf][k] & 0xffffu) * bf2f(v1[hf][k] & 0xffffu), h1b = bf2f(c1[hf][k] >> 16) * bf2f(v1[hf][k] >> 16);
                    const float h2a = bf2f(c2[hf][k] & 0xffffu) * bf2f(v2[hf][k] & 0xffffu), h2b = bf2f(c2[hf][k] >> 16) * bf2f(v2[hf][k] >> 16);
                    const float ya = bf2f(b0[hf][k] & 0xffffu) * (w0a * h2a + w1a * h1a + w2a * h0a), yb = bf2f(b0[hf][k] >> 16) * (w0b * h2b + w1b * h1b + w2b * h0b);
                    o[k] = cvt_pk_bf16(ya, yb); }
                oh[hf] = (u32x4){o[0], o[1], o[2], o[3]};
            }
            {
                const f32x4 pa = __builtin_bit_cast(f32x4, oh[0]), pb = __builtin_bit_cast(f32x4, oh[1]); const bool odd_ = (tid & 1) != 0;
                bf16* yq = y + tok * DM + g * 64 + 8 * (tid & 3);
                *(u32x4*)yq = __builtin_bit_cast(u32x4, quad_piece<0x50>(pa, pb, odd_)); *(u32x4*)(yq + 32) = __builtin_bit_cast(u32x4, quad_piece<0xFA>(pa, pb, odd_)); }
        }
        __syncthreads();
        {
            const int li = lane & 15, kq = lane >> 4;
            f32x4 acc[4];
#pragma unroll
            for (int cb = 0; cb < 4; ++cb) acc[cb] = (f32x4){0.f, 0.f, 0.f, 0.f};
#pragma unroll
            for (int ks = 0; ks < 4; ++ks) {
                const bf16x8 bfrag = wfr[ks];
#pragma unroll
                for (int cb = 0; cb < 4; ++cb) {
                    const LAS unsigned char* ap = lds + (32 * ks + 8 * kq + (li >> 2)) * VST + (16 * cb + 4 * (li & 3)) * 2;
                    const s16x4 lo = __builtin_bit_cast(s16x4, __builtin_amdgcn_ds_read_tr16_b64_v4i16((LAS s16x4*)ap));
                    const s16x4 hi = __builtin_bit_cast(s16x4, __builtin_amdgcn_ds_read_tr16_b64_v4i16((LAS s16x4*)(ap + 4 * VST)));
                    const bf16x8 afrag = (bf16x8){lo[0], lo[1], lo[2], lo[3], hi[0], hi[1], hi[2], hi[3]};
                    acc[cb] = __builtin_amdgcn_mfma_f32_16x16x32_bf16(afrag, bfrag, acc[cb], 0, 0, 0); } }
            const int irow = 16 * wid + li; const size_t trow = (size_t)blk * 128 + irow; const float bias = sgu_b[g * 128 + irow];
#pragma unroll
            for (int cb = 0; cb < 4; ++cb) { const int cg = g * 64 + 16 * cb + 4 * kq;
                const u32x2 ur = *(const u32x2*)(proj + trow * EVEN_IN + 1536 + cg);
                u32x2 o; o.x = cvt_pk_bf16(bf2f(ur.x & 0xffffu) * (acc[cb][0] + bias), bf2f(ur.x >> 16) * (acc[cb][1] + bias)); o.y = cvt_pk_bf16(bf2f(ur.y & 0xffffu) * (acc[cb][2] + bias), bf2f(ur.y >> 16) * (acc[cb][3] + bias));
                *(u32x2*)(y + trow * DM + 512 + cg) = o; }
        }
        __syncthreads();
    }
}

__device__ __forceinline__ float log_sigmoid(float z) { return fminf(z, 0.0f) - log1pf(expf(-fabsf(z))); }
__device__ __forceinline__ void odd_mid_phase(const bf16* proj, const float* fz, const float* fbias, bf16* cqn, bf16* ckvn, bf16* krope, float* fb, const float* cosT, const float* sinT, unsigned* kmax, int G, int c) {
    int tid_ = threadIdx.x; asm volatile("" : "+v"(tid_));
    const int tid = tid_, lane = tid & 63, wid = __builtin_amdgcn_readfirstlane(tid >> 6);
    const int gw = c * 8 + wid, NGW = G * 8;
    for (int blk = gw; blk < NTOK / 16; blk += NGW) {
        float km = 0.f;
        for (int r = 0; r < 16; ++r) {
            const int row = blk * 16 + r;
            const bf16* p = proj + (size_t)row * ODD_LD;
            const u32x2 a = *(const u32x2*)(p + 4 * lane); const unsigned b = *(const unsigned*)(p + 256 + 2 * lane);
            const u32x4 kk = *(const u32x4*)(p + 928 + 8 * lane);
            const float q0 = bf2f(a.x & 0xffffu), q1 = bf2f(a.x >> 16), q2 = bf2f(a.y & 0xffffu), q3 = bf2f(a.y >> 16), k0 = bf2f(b & 0xffffu), k1 = bf2f(b >> 16);
            const float rq = 1.0f / sqrtf(wave_sum(q0 * q0 + q1 * q1 + q2 * q2 + q3 * q3) * (1.0f / 256.0f) + LN_EPS);
            const float rk = 1.0f / sqrtf(wave_sum(k0 * k0 + k1 * k1) * (1.0f / 128.0f) + LN_EPS);
            u32x2 o; o.x = cvt_pk_bf16(q0 * rq, q1 * rq); o.y = cvt_pk_bf16(q2 * rq, q3 * rq);
            *(u32x2*)(cqn + (size_t)row * 256 + 4 * lane) = o;
            *(unsigned*)(ckvn + (size_t)row * 256 + 2 * lane) = cvt_pk_bf16(k0 * rk, k1 * rk);
            *(unsigned*)(ckvn + (size_t)row * 256 + 128 + 2 * lane) = 0u;
            if (lane < 16) { const float x1 = bf2f(p[384 + lane]), x2 = bf2f(p[400 + lane]); const int pos = row & (SEQ - 1); const float cs = cosT[pos * 16 + lane], sn = sinT[pos * 16 + lane];
                *(unsigned*)(krope + (size_t)row * 32 + 2 * lane) = cvt_pk_bf16(x1 * cs - x2 * sn, x2 * cs + x1 * sn); }
            float ks = 0.f;
#pragma unroll
            for (int i = 0; i < 4; ++i) { const float lo = bf2f(kk[i] & 0xffffu), hi = bf2f(kk[i] >> 16); ks += lo * lo + hi * hi; }
            ks += __shfl_xor(ks, 1); ks += __shfl_xor(ks, 2); ks += __shfl_xor(ks, 4);
            km = fmaxf(km, ks);
        }
        if ((lane & 7) == 0) atomicMax(kmax + ((blk * 16) >> 12) * 8 + (lane >> 3), __float_as_uint(km));
    }
    if (gw < 64) {
        const int b = gw >> 3, h = gw & 7; const float bias = fbias[h];
        const float* zp = fz + ((size_t)b * SEQ + (size_t)lane * 64) * 8 + h;
        float s = 0.f;
        for (int i = 0; i < 64; ++i) s += log_sigmoid(zp[(size_t)i * 8] + bias);
        float incl = s;
#pragma unroll
        for (int o = 1; o < 64; o <<= 1) { const float t = __shfl_up(incl, o); if (lane >= o) incl += t; }
        float run = incl - s;
        float* op = fb + (size_t)gw * SEQ + lane * 64;
        for (int i = 0; i < 64; ++i) { run += log_sigmoid(zp[(size_t)i * 8] + bias); op[i] = -run * LOG2E; }
    }
}

__device__ __forceinline__ int crow(int r, int hi) { return (r & 3) + 8 * (r >> 2) + 4 * hi; }
template <int MODE>
__device__ __forceinline__ void attn_unit(LAS unsigned char* lds, int b, int h, int qb, const bf16* qsrc, const bf16* kvsrc, const bf16* krope, const bf16* proj, const float* fb, bf16* y, const unsigned* kmax) {
    constexpr int DQ = MODE == 0 ? 96 : 64, ND = DQ / 16, KST = DQ * 2 + 16, VST = 192;
    constexpr int K_OFF = 0, V_OFF = 64 * KST, B_OFF = V_OFF + 64 * VST, BUFB = B_OFF + 256;
    constexpr float THR = 8.0f;
    int tid_ = threadIdx.x; asm volatile("" : "+v"(tid_));
    const int tid = tid_, lane = tid & 63, r32 = lane & 31, hi = lane >> 5, wid = __builtin_amdgcn_readfirstlane(tid >> 6);
    const size_t rowbase = (size_t)b * SEQ; const int q0 = qb * 256;
    const int qrow = q0 + wid * 32 + r32;
    bf16x8 qr[ND];
    { const bf16* qp = (MODE == 0) ? qsrc + (rowbase + qrow) * 768 + h * 96 + hi * 8 : proj + (rowbase + qrow) * ODD_LD + 416 + h * 64 + hi * 8;
#pragma unroll
      for (int d0 = 0; d0 < ND; ++d0) qr[d0] = *(const bf16x8*)(qp + d0 * 16); }
    const int NT = (q0 + 256) / 64;
    const int wlast = (q0 + wid * 32) / 64;
    int wfirst = 0, T0 = 0;
    if (MODE == 1) {
        float qs = 0.f, dk = 0.f;
        { const bf16* kp0 = proj + (rowbase + qrow) * ODD_LD + 928 + h * 64 + hi * 8;
          bf16x8 kr[ND];
#pragma unroll
          for (int d0 = 0; d0 < ND; ++d0) kr[d0] = *(const bf16x8*)(kp0 + d0 * 16);
#pragma unroll
          for (int d0 = 0; d0 < ND; ++d0)
#pragma unroll
            for (int i = 0; i < 8; ++i) { const float f = bf2f((unsigned)(unsigned short)qr[d0][i]), kf = bf2f((unsigned)(unsigned short)kr[d0][i]); qs += f * f; dk += f * kf; } }
        qs += __shfl_xor(qs, 32); dk += __shfl_xor(dk, 32);
        const float km2 = __uint_as_float(kmax[b * 8 + h]);
        const float* fbh = fb + ((size_t)(b * 8 + h)) * SEQ;
        float gmin = fbh[qrow] + dk - 43.4f - 1.01f * sqrtf(qs) * sqrtf(km2);
#pragma unroll
        for (int o = 16; o >= 1; o >>= 1) gmin = fminf(gmin, __shfl_xor(gmin, o));
        const float fj = fbh[64 * lane + 63];
        const unsigned long long sk = __ballot(lane < wlast && fj <= gmin);
        wfirst = __builtin_amdgcn_readfirstlane((int)__builtin_ctzll(~sk));
        LAS int* wf = (LAS int*)(lds + 5 * BUFB);
        if (lane == 0) wf[wid] = wfirst;
        __syncthreads();
        int m = wf[0];
#pragma unroll
        for (int w = 1; w < 8; ++w) m = min(m, wf[w]);
        T0 = __builtin_amdgcn_readfirstlane(m);
    }
    const int lr = tid >> 3, lc = tid & 7;
    const bf16* kg = (MODE == 0) ? kvsrc + (rowbase + lr) * 1024 + h * 128 + lc * 8 : proj + (rowbase + lr) * ODD_LD + 928 + h * 64 + lc * 8;
    const bf16* vg = (MODE == 0) ? kvsrc + (rowbase + lr) * 1024 + h * 128 + 64 + lc * 8 : proj + (rowbase + lr) * ODD_LD + 1440 + h * 64 + lc * 8;
    const size_t kvstep = (size_t)64 * ((MODE == 0) ? 1024 : ODD_LD);
    const bf16* rg = krope + (rowbase + ((tid & 255) >> 2)) * 32 + (tid & 3) * 8;
    const float* bg = fb + ((size_t)(b * 8 + h)) * SEQ + (tid & 63);
    u32x4 kreg[3], vreg[3], rreg[3]; float breg[3]; rreg[0] = rreg[1] = rreg[2] = (u32x4){0u, 0u, 0u, 0u}; breg[0] = breg[1] = breg[2] = 0.f;
#define ATT_GLOAD(t, S_) do { const int tt_ = min((int)(t), NT - 1); kreg[S_] = *(const u32x4*)(kg + (size_t)tt_ * kvstep); vreg[S_] = *(const u32x4*)(vg + (size_t)tt_ * kvstep); \
        if (MODE == 0) rreg[S_] = *(const u32x4*)(rg + (size_t)tt_ * 64 * 32); else breg[S_] = bg[tt_ * 64]; } while (0)
#define ATT_LSTORE(bo, S_) do { LAS unsigned char* bp_ = lds + (bo); *(LAS u32x4*)(bp_ + K_OFF + lr * KST + lc * 16) = kreg[S_]; *(LAS u32x4*)(bp_ + V_OFF + lr * VST + lc * 16) = vreg[S_]; \
        if (MODE == 0) { if (tid < 256) *(LAS u32x4*)(bp_ + K_OFF + (tid >> 2) * KST + 128 + (tid & 3) * 16) = rreg[S_]; } else { if (tid < 64) *(LAS float*)(bp_ + B_OFF + tid * 4) = breg[S_]; } } while (0)
#define ATT_QK(S, bo) do { const LAS unsigned char* bq_ = lds + (bo); \
        bf16x8 kf_[2][ND];     \
        _Pragma("unroll") for (int hh = 0; hh < 2; ++hh) { const LAS unsigned char* kp_ = bq_ + K_OFF + (32 * hh + r32) * KST + hi * 16; \
            _Pragma("unroll") for (int d0 = 0; d0 < ND; ++d0) kf_[hh][d0] = *(const LAS bf16x8*)(kp_ + d0 * 32); } \
        _Pragma("unroll") for (int hh = 0; hh < 2; ++hh) { \
            if (MODE == 1) { _Pragma("unroll") for (int rr = 0; rr < 4; ++rr) { const f32x4 bv_ = *(const LAS f32x4*)(bq_ + B_OFF + (32 * hh + 8 * rr + 4 * hi) * 4); \
                S[hh][4 * rr] = bv_[0] - mref; S[hh][4 * rr + 1] = bv_[1] - mref; S[hh][4 * rr + 2] = bv_[2] - mref; S[hh][4 * rr + 3] = bv_[3] - mref; } } \
            else { _Pragma("unroll") for (int r = 0; r < 16; ++r) S[hh][r] = -mref; } } \
        __builtin_amdgcn_sched_barrier(0); \
        _Pragma("unroll") for (int d0 = 0; d0 < ND; ++d0) _Pragma("unroll") for (int hh = 0; hh < 2; ++hh) S[hh] = __builtin_amdgcn_mfma_f32_32x32x16_bf16(kf_[hh][d0], qr[d0], S[hh], 0, 0, 0); \
        __builtin_amdgcn_sched_barrier(0); } while (0)
#define ATT_VLOAD(VF, bo) do { const LAS unsigned char* bv0_ = lds + (bo); \
        _Pragma("unroll") for (int hh = 0; hh < 2; ++hh) _Pragma("unroll") for (int s_ = 0; s_ < 2; ++s_) _Pragma("unroll") for (int d0 = 0; d0 < 2; ++d0) { \
            const LAS unsigned char* vp_ = bv0_ + V_OFF + (32 * hh + 16 * s_ + 4 * hi + ((lane & 15) >> 2)) * VST + (32 * d0 + 16 * ((lane >> 4) & 1) + 4 * (lane & 3)) * 2; \
            const s16x4 lo_ = __builtin_bit_cast(s16x4, __builtin_amdgcn_ds_read_tr16_b64_v4i16((LAS s16x4*)vp_)); \
            const s16x4 hv_ = __builtin_bit_cast(s16x4, __builtin_amdgcn_ds_read_tr16_b64_v4i16((LAS s16x4*)(vp_ + 8 * VST))); \
            VF[hh][s_][d0] = (bf16x8){lo_[0], lo_[1], lo_[2], lo_[3], hv_[0], hv_[1], hv_[2], hv_[3]}; } } while (0)
    float mref = 0.f, lsum = 0.f; f32x16 o[2]; o[0] = f32x16{}; o[1] = f32x16{};
    bool fresh = true;
    int b0 = 0, b1 = BUFB, b2 = 2 * BUFB, b3 = 3 * BUFB, b4 = 4 * BUFB;
    ATT_GLOAD(T0, 0); ATT_GLOAD(T0 + 1, 1); ATT_GLOAD(T0 + 2, 2);
    ATT_LSTORE(b0, 0); if (T0 + 1 < NT) ATT_LSTORE(b1, 1); if (T0 + 2 < NT) ATT_LSTORE(b2, 2);
    ATT_GLOAD(T0 + 3, 0); ATT_GLOAD(T0 + 4, 1);
    __syncthreads();
    f32x16 sA[2], sB[2];
    if (T0 >= wfirst && T0 <= wlast) ATT_QK(sA, b0);
#define ATT_STEP(SC, SN, t, S_, BAR_) do { \
        if ((t) + 3 < NT) ATT_LSTORE(b3, S_);      \
        ATT_GLOAD((t) + 5, S_); \
        const bool doS_ = ((t) + 1 < NT) && ((t) + 1 >= wfirst) && ((t) + 1 <= wlast); \
        const bool doP_ = ((t) >= wfirst) && ((t) <= wlast); \
        if (doS_) ATT_QK(SN, b1); \
        if (doP_) { \
            bf16x8 vf_[2][2][2]; ATT_VLOAD(vf_, b0); __builtin_amdgcn_sched_barrier(0); \
            if (MODE == 1 && (t) == wlast) { \
                _Pragma("unroll") for (int hh = 0; hh < 2; ++hh) _Pragma("unroll") for (int r = 0; r < 16; ++r) { const int kv_ = 64 * (t) + 32 * hh + crow(r, hi); if (kv_ > qrow) SC[hh][r] = -INFINITY; } } \
            float mx_ = fmaxf(fmaxf(SC[0][0], SC[0][1]), SC[1][0]); \
            _Pragma("unroll") for (int r = 2; r < 16; r += 2) mx_ = fmaxf(fmaxf(mx_, SC[0][r]), SC[0][r + 1]); \
            _Pragma("unroll") for (int r = 1; r < 15; r += 2) mx_ = fmaxf(fmaxf(mx_, SC[1][r]), SC[1][r + 1]); \
            mx_ = fmaxf(mx_, SC[1][15]); \
            { auto rr_ = __builtin_amdgcn_permlane32_swap(__float_as_uint(mx_), __float_as_uint(mx_), false, false); mx_ = fmaxf(__uint_as_float(rr_[0]), __uint_as_float(rr_[1])); } \
            if (fresh || __any(mx_ > THR)) { \
                const float dl_ = fresh ? mx_ : fmaxf(mx_, 0.f); mref += dl_; \
                _Pragma("unroll") for (int hh = 0; hh < 2; ++hh) _Pragma("unroll") for (int r = 0; r < 16; ++r) SC[hh][r] -= dl_; \
                if (doS_) { _Pragma("unroll") for (int hh = 0; hh < 2; ++hh) _Pragma("unroll") for (int r = 0; r < 16; ++r) SN[hh][r] -= dl_; } \
                if (!fresh) { const float al_ = __builtin_amdgcn_exp2f(-dl_); lsum *= al_; \
                    _Pragma("unroll") for (int d0 = 0; d0 < 2; ++d0) _Pragma("unroll") for (int r = 0; r < 16; ++r) o[d0][r] *= al_; } \
                fresh = false; } \
            float ps_ = 0.f; \
            _Pragma("unroll") for (int hh = 0; hh < 2; ++hh) _Pragma("unroll") for (int r = 0; r < 16; ++r) { SC[hh][r] = __builtin_amdgcn_exp2f(SC[hh][r]); ps_ += SC[hh][r]; } \
            lsum += ps_; \
            __builtin_amdgcn_sched_barrier(0); \
            _Pragma("unroll") for (int hh = 0; hh < 2; ++hh) _Pragma("unroll") for (int s_ = 0; s_ < 2; ++s_) { \
                u32x4 pw_; pw_.x = cvt_pk_bf16(SC[hh][8 * s_], SC[hh][8 * s_ + 1]); pw_.y = cvt_pk_bf16(SC[hh][8 * s_ + 2], SC[hh][8 * s_ + 3]); pw_.z = cvt_pk_bf16(SC[hh][8 * s_ + 4], SC[hh][8 * s_ + 5]); pw_.w = cvt_pk_bf16(SC[hh][8 * s_ + 6], SC[hh][8 * s_ + 7]); \
                const bf16x8 pf_ = __builtin_bit_cast(bf16x8, pw_); \
                _Pragma("unroll") for (int d0 = 0; d0 < 2; ++d0) o[d0] = __builtin_amdgcn_mfma_f32_32x32x16_bf16(vf_[hh][s_][d0], pf_, o[d0], 0, 0, 0); } } \
        if (BAR_) __syncthreads(); \
        { const int tb_ = b0; b0 = b1; b1 = b2; b2 = b3; b3 = b4; b4 = tb_; } } while (0)
    int t = T0;
    for (; t + 1 < NT; t += 2) { ATT_STEP(sA, sB, t, 0, 0); ATT_STEP(sB, sA, t + 1, 1, 1); }
    if (t < NT) ATT_STEP(sA, sB, t, 0, 1);
#undef ATT_STEP
#undef ATT_QK
#undef ATT_VLOAD
#undef ATT_GLOAD
#undef ATT_LSTORE
    lsum += __shfl_xor(lsum, 32);
    const float rl = 1.0f / lsum;
    LAS unsigned char* ys = lds + wid * 4608;
#pragma unroll
    for (int d0 = 0; d0 < 2; ++d0)
#pragma unroll
        for (int rr = 0; rr < 4; ++rr) { u32x2 w; w.x = cvt_pk_bf16(o[d0][4 * rr] * rl, o[d0][4 * rr + 1] * rl); w.y = cvt_pk_bf16(o[d0][4 * rr + 2] * rl, o[d0][4 * rr + 3] * rl);
            *(LAS u32x2*)(ys + r32 * 144 + (32 * d0 + 8 * rr + 4 * hi) * 2) = w; }
    bf16* yb_ = y + (rowbase + q0 + wid * 32) * DM + (MODE == 0 ? 0 : 512) + h * 64 + 8 * (lane & 7);
#pragma unroll
    for (int i = 0; i < 4; ++i) { const int row = 8 * i + (lane >> 3); const u32x4 v = *(const LAS u32x4*)(ys + row * 144 + 16 * (lane & 7)); *(u32x4*)(yb_ + (size_t)row * DM) = v; }
}
__device__ __forceinline__ void attn_phase(LAS unsigned char* lds, const bf16* q, const bf16* kv, const bf16* krope, const bf16* proj, const float* fb, bf16* y, const unsigned* kmax, unsigned* qhead) {
    LAS int* qslot = (LAS int*)(lds + 135168);
    unsigned nxt_idx = 0u;
    if (threadIdx.x == 0) qslot[0] = (int)__hip_atomic_fetch_add(qhead, 1u, __ATOMIC_RELAXED, __HIP_MEMORY_SCOPE_AGENT);
    __syncthreads();
    int idx = qslot[0];
    while (idx < 2048) {
        __syncthreads();
        if (threadIdx.x == 0) nxt_idx = __hip_atomic_fetch_add(qhead, 1u, __ATOMIC_RELAXED, __HIP_MEMORY_SCOPE_AGENT);
        const int kind = idx >> 10, id = idx & 1023, qb = 15 - (id >> 6), bh = id & 63;
        if (kind == 0) attn_unit<0>(lds, bh >> 3, bh & 7, qb, q, kv, krope, proj, fb, y, kmax);
        else attn_unit<1>(lds, bh >> 3, bh & 7, qb, q, kv, krope, proj, fb, y, kmax);
        if (threadIdx.x == 0) qslot[0] = (int)nxt_idx;
        __syncthreads();
        idx = qslot[0];
    }
}

__device__ __forceinline__ f32x4 ld_bf4(const bf16* p) { const u32x2 r = *(const u32x2*)p; f32x4 v; v[0] = bf2f(r.x & 0xffffu); v[1] = bf2f(r.x >> 16); v[2] = bf2f(r.y & 0xffffu); v[3] = bf2f(r.y >> 16); return v; }
__device__ __forceinline__ void st_bf4(bf16* p, f32x4 v) { u32x2 o; o.x = cvt_pk_bf16(v[0], v[1]); o.y = cvt_pk_bf16(v[2], v[3]); *(u32x2*)p = o; }
__device__ __forceinline__ float hsum4(f32x4 v) { return (v[0] + v[1]) + (v[2] + v[3]); }

__device__ __forceinline__ void ln1_phase(LAS unsigned char* lds, const bf16* pre, const bf16* xres, bf16* xb, bf16* xl, unsigned char* x8, const float* g, const float* b, const bf16* wrt, const float* brt, unsigned* cnt, unsigned* list, float* glist, unsigned* tokinfo, int G, int c) {
    int tid_ = threadIdx.x; asm volatile("" : "+v"(tid_));
    const int tid = tid_, lane = tid & 63, wid = __builtin_amdgcn_readfirstlane(tid >> 6);
    LAS float* scr = (LAS float*)(lds + 131072) + wid * 512;
    LAS unsigned* rec_e = (LAS unsigned*)(lds + 147456);
    LAS float* rec_g = (LAS float*)(lds + 149504);
    LAS unsigned* lcnt = (LAS unsigned*)(lds + 151552);
    LAS unsigned* gbase = (LAS unsigned*)(lds + 151680);
    { f32x4 wv[16];
#pragma unroll
      for (int i = 0; i < 16; ++i) wv[i] = ((const f32x4*)wrt)[tid + 512 * i];
#pragma unroll
      for (int i = 0; i < 16; ++i) ((LAS f32x4*)lds)[tid + 512 * i] = wv[i]; }
    f32x4 g4[4], b4[4];
#pragma unroll
    for (int q = 0; q < 4; ++q) { const int cq = 8 * lane + 512 * (q >> 1) + 4 * (q & 1); g4[q] = *(const f32x4*)(g + cq); b4[q] = *(const f32x4*)(b + cq); }
    const float br = brt[lane & 31];
    for (int chunk = c; chunk < NTOK / 128; chunk += G) {
        if (tid < 32) lcnt[tid] = 0u;
        __syncthreads();
        const int row0 = chunk * 128 + wid * 16;
        u32x4 raw[4][2], rax[4][2];
#pragma unroll
        for (int rr = 0; rr < 4; ++rr)
#pragma unroll
            for (int j = 0; j < 2; ++j) { raw[rr][j] = *(const u32x4*)(pre + (size_t)(row0 + rr) * DM + 8 * lane + 512 * j); rax[rr][j] = *(const u32x4*)(xres + (size_t)(row0 + rr) * DM + 8 * lane + 512 * j); }
        for (int it = 0; it < 4; ++it) {
            const int rbase = row0 + it * 4;
            f32x4 v[4][4];
#pragma unroll
            for (int rr = 0; rr < 4; ++rr)
#pragma unroll
                for (int j = 0; j < 2; ++j) { const u32x4 m_ = raw[rr][j], x_ = rax[rr][j];
                    v[rr][2 * j][0] = bf2f(m_.x & 0xffffu) + DN_ALPHA * bf2f(x_.x & 0xffffu); v[rr][2 * j][1] = bf2f(m_.x >> 16) + DN_ALPHA * bf2f(x_.x >> 16);
                    v[rr][2 * j][2] = bf2f(m_.y & 0xffffu) + DN_ALPHA * bf2f(x_.y & 0xffffu); v[rr][2 * j][3] = bf2f(m_.y >> 16) + DN_ALPHA * bf2f(x_.y >> 16);
                    v[rr][2 * j + 1][0] = bf2f(m_.z & 0xffffu) + DN_ALPHA * bf2f(x_.z & 0xffffu); v[rr][2 * j + 1][1] = bf2f(m_.z >> 16) + DN_ALPHA * bf2f(x_.z >> 16);
                    v[rr][2 * j + 1][2] = bf2f(m_.w & 0xffffu) + DN_ALPHA * bf2f(x_.w & 0xffffu); v[rr][2 * j + 1][3] = bf2f(m_.w >> 16) + DN_ALPHA * bf2f(x_.w >> 16); }
            if (it < 3) {
#pragma unroll
                for (int rr = 0; rr < 4; ++rr)
#pragma unroll
                    for (int j = 0; j < 2; ++j) { raw[rr][j] = *(const u32x4*)(pre + (size_t)(rbase + 4 + rr) * DM + 8 * lane + 512 * j); rax[rr][j] = *(const u32x4*)(xres + (size_t)(rbase + 4 + rr) * DM + 8 * lane + 512 * j); } }
#pragma unroll
            for (int rr = 0; rr < 4; ++rr) {
                float s = 0.f;
#pragma unroll
                for (int q = 0; q < 4; ++q) s += hsum4(v[rr][q]);
                const float mean = wave_sum(s) * (1.0f / DM); float qv = 0.f;
#pragma unroll
                for (int q = 0; q < 4; ++q) { v[rr][q] = v[rr][q] - mean; qv += hsum4(v[rr][q] * v[rr][q]); }
                const float rstd = 1.0f / sqrtf(wave_sum(qv) * (1.0f / DM) + LN_EPS);
#pragma unroll
                for (int j = 0; j < 2; ++j) { const f32x4 x0 = v[rr][2 * j] * rstd * g4[2 * j] + b4[2 * j], x1 = v[rr][2 * j + 1] * rstd * g4[2 * j + 1] + b4[2 * j + 1];
                    const size_t o = (size_t)(rbase + rr) * DM + 8 * lane + 512 * j;
                    u32x4 h; h.x = cvt_pk_bf16(x0[0], x0[1]); h.y = cvt_pk_bf16(x0[2], x0[3]); h.z = cvt_pk_bf16(x1[0], x1[1]); h.w = cvt_pk_bf16(x1[2], x1[3]); *(u32x4*)(xb + o) = h;
                    u32x4 l; l.x = cvt_pk_bf16(x0[0] - bf2f(h.x & 0xffffu), x0[1] - bf2f(h.x >> 16)); l.y = cvt_pk_bf16(x0[2] - bf2f(h.y & 0xffffu), x0[3] - bf2f(h.y >> 16));
                    l.z = cvt_pk_bf16(x1[0] - bf2f(h.z & 0xffffu), x1[1] - bf2f(h.z >> 16)); l.w = cvt_pk_bf16(x1[2] - bf2f(h.w & 0xffffu), x1[3] - bf2f(h.w >> 16)); *(u32x4*)(xl + o) = l;
                    u32x2 e8; e8.x = pg8::pk_fp8x4(x0[0], x0[1], x0[2], x0[3]); e8.y = pg8::pk_fp8x4(x1[0], x1[1], x1[2], x1[3]); *(u32x2*)(x8 + o) = e8; }
            }
        }
        asm volatile("s_waitcnt vmcnt(0)" ::: "memory");
        __builtin_amdgcn_fence(__ATOMIC_ACQUIRE, "workgroup");
        {
            const int li = lane & 15, kq = lane >> 4;
            const bf16* ah_p = xb + (size_t)(row0 + li) * DM + 8 * kq; const bf16* al_p = xl + (size_t)(row0 + li) * DM + 8 * kq;
            f32x4 acc[2]; acc[0] = (f32x4){0.f, 0.f, 0.f, 0.f}; acc[1] = acc[0];
            bf16x8 ah[2][4], al[2][4];
#pragma unroll
            for (int k4 = 0; k4 < 4; ++k4) { ah[0][k4] = *(const bf16x8*)(ah_p + 32 * k4); al[0][k4] = *(const bf16x8*)(al_p + 32 * k4); }
#define LN1_MMA(buf, bt_) do { _Pragma("unroll") for (int k4 = 0; k4 < 4; ++k4) { const int ks = 4 * (bt_) + k4; \
                _Pragma("unroll") for (int nb = 0; nb < 2; ++nb) { const int e = 16 * nb + li; const LAS unsigned char* wp = lds + e * 2048 + (((4 * ks + kq) ^ li) << 4); \
                    const bf16x8 wh = *(const LAS bf16x8*)wp, wl = *(const LAS bf16x8*)(wp + 65536); \
                    acc[nb] = __builtin_amdgcn_mfma_f32_16x16x32_bf16(ah[buf][k4], wh, acc[nb], 0, 0, 0); \
                    acc[nb] = __builtin_amdgcn_mfma_f32_16x16x32_bf16(al[buf][k4], wh, acc[nb], 0, 0, 0); \
                    acc[nb] = __builtin_amdgcn_mfma_f32_16x16x32_bf16(ah[buf][k4], wl, acc[nb], 0, 0, 0); } } } while (0)
#pragma unroll 1
            for (int bt = 0; bt < 8; bt += 2) {
#pragma unroll
                for (int k4 = 0; k4 < 4; ++k4) { ah[1][k4] = *(const bf16x8*)(ah_p + 32 * (4 * (bt + 1) + k4)); al[1][k4] = *(const bf16x8*)(al_p + 32 * (4 * (bt + 1) + k4)); }
                LN1_MMA(0, bt);
                if (bt < 6) {
#pragma unroll
                    for (int k4 = 0; k4 < 4; ++k4) { ah[0][k4] = *(const bf16x8*)(ah_p + 32 * (4 * (bt + 2) + k4)); al[0][k4] = *(const bf16x8*)(al_p + 32 * (4 * (bt + 2) + k4)); } }
                LN1_MMA(1, bt + 1);
            }
#undef LN1_MMA
#pragma unroll
            for (int nb = 0; nb < 2; ++nb)
#pragma unroll
                for (int r = 0; r < 4; ++r) scr[(4 * kq + r) * 32 + 16 * nb + li] = acc[nb][r];
        }
        asm volatile("s_waitcnt lgkmcnt(0)" ::: "memory");
        const int half = lane >> 5, e = lane & 31;
#pragma unroll 1
        for (int ps = 0; ps < 8; ++ps) {
            const int rr = 2 * ps + half;
            float val = scr[rr * 32 + e] + br;
            float tv[4]; int te[4];
#pragma unroll
            for (int k = 0; k < 4; ++k) {
                float m = val;
                m = fmaxf(m, __shfl_xor(m, 16)); m = fmaxf(m, __shfl_xor(m, 8)); m = fmaxf(m, __shfl_xor(m, 4)); m = fmaxf(m, __shfl_xor(m, 2)); m = fmaxf(m, __shfl_xor(m, 1));
                const unsigned long long bal = __ballot(val == m);
                const unsigned hm = half ? (unsigned)(bal >> 32) : (unsigned)bal;
                const int sel = __ffs((int)hm) - 1;
                tv[k] = m; te[k] = sel; if (e == sel) val = -INFINITY;
            }
            const float w1 = __expf(tv[1] - tv[0]), w2 = __expf(tv[2] - tv[0]), w3 = __expf(tv[3] - tv[0]);
            const float inv = 1.0f / (1.0f + w1 + w2 + w3);
            if (e < 4) {
                const int me = (e == 0) ? te[0] : (e == 1) ? te[1] : (e == 2) ? te[2] : te[3];
                const float mg = ((e == 0) ? 1.0f : (e == 1) ? w1 : (e == 2) ? w2 : w3) * inv;
                const unsigned lrank = __hip_atomic_fetch_add(lcnt + me, 1u, __ATOMIC_RELAXED, __HIP_MEMORY_SCOPE_WORKGROUP);
                const int ri = (wid * 16 + rr) * 4 + e;
                rec_e[ri] = (unsigned)me | (lrank << 8); rec_g[ri] = mg;
            }
        }
        __syncthreads();
        if (tid < 32) gbase[tid] = __hip_atomic_fetch_add(cnt + tid * CNT_STRIDE, lcnt[tid], __ATOMIC_RELAXED, __HIP_MEMORY_SCOPE_AGENT);
        __syncthreads();
        { const unsigned re = rec_e[tid]; const int e2 = (int)(re & 0xffu); const unsigned rank = gbase[e2] + (re >> 8); const unsigned tk = (unsigned)(chunk * 128 + (tid >> 2)) * 4u + (unsigned)(tid & 3);
          list[(size_t)e2 * CAP + rank] = tk; glist[(size_t)e2 * CAP + rank] = rec_g[tid]; tokinfo[tk] = ((unsigned)e2 << 24) | rank; }
        __syncthreads();
    }
}

__device__ __forceinline__ void unpack8(const u32x4 r, f32x4& a, f32x4& b) { a[0] = bf2f(r.x & 0xffffu); a[1] = bf2f(r.x >> 16); a[2] = bf2f(r.y & 0xffffu); a[3] = bf2f(r.y >> 16); b[0] = bf2f(r.z & 0xffffu); b[1] = bf2f(r.z >> 16); b[2] = bf2f(r.w & 0xffffu); b[3] = bf2f(r.w >> 16); }
__device__ __forceinline__ f32x4 unpack_fp8x4(unsigned w) { const f32x2 lo = __builtin_amdgcn_cvt_pk_f32_fp8((int)w, false), hi = __builtin_amdgcn_cvt_pk_f32_fp8((int)w, true); return (f32x4){lo.x, lo.y, hi.x, hi.y}; }
__device__ __forceinline__ void ln2_phase(const unsigned char* out2, const bf16* xb, bf16* xo, const float* g, const float* b, const unsigned* cnt, const unsigned* tokinfo, float* outf, int G, int c) {
    int tid_ = threadIdx.x; asm volatile("" : "+v"(tid_));
    const int tid = tid_, lane = tid & 63, wid = __builtin_amdgcn_readfirstlane(tid >> 6);
    unsigned offs;
    { const unsigned cn = (lane < NEXP) ? __hip_atomic_load(cnt + lane * CNT_STRIDE, __ATOMIC_RELAXED, __HIP_MEMORY_SCOPE_AGENT) : 0u; const unsigned mt = (cn + 255u) >> 8; unsigned incl = mt;
#pragma unroll
      for (int o = 1; o < 64; o <<= 1) { const unsigned t = __shfl_up(incl, o); if (lane >= o) incl += t; }
      offs = (incl - mt) * 256u; }
    f32x4 g4[4], b4[4];
#pragma unroll
    for (int q = 0; q < 4; ++q) { const int cq = 8 * lane + 512 * (q >> 1) + 4 * (q & 1); g4[q] = *(const f32x4*)(g + cq); b4[q] = *(const f32x4*)(b + cq); }
    for (int blk = c * 8 + wid; blk < NTOK / 16; blk += G * 8) {
        const int row0 = blk * 16;
        const unsigned info = tokinfo[(size_t)row0 * 4 + lane];
        const unsigned slot = (unsigned)__shfl((int)offs, (int)(info >> 24)) + (info & 0xffffffu);
        u32x4 cx[2], ce[4], nx[2], ne[4];
        { const bf16* xp_ = xb + (size_t)row0 * DM + 8 * lane; cx[0] = *(const u32x4*)xp_; cx[1] = *(const u32x4*)(xp_ + 512);
#pragma unroll
          for (int k = 0; k < 4; ++k) { const unsigned sl_ = (unsigned)__builtin_amdgcn_readlane((int)slot, k); const unsigned char* ep_ = out2 + (size_t)sl_ * DM + 8 * lane;
              const u32x2 ea_ = *(const u32x2*)ep_, eb_ = *(const u32x2*)(ep_ + 512); ce[k] = (u32x4){ea_.x, ea_.y, eb_.x, eb_.y}; } }
#pragma unroll 1
        for (int r = 0; r < 16; ++r) {
            const int rn = (r < 15) ? r + 1 : 15;
            {
                const bf16* xp_ = xb + (size_t)(row0 + rn) * DM + 8 * lane; nx[0] = *(const u32x4*)xp_; nx[1] = *(const u32x4*)(xp_ + 512);
#pragma unroll
                for (int k = 0; k < 4; ++k) { const unsigned sl_ = (unsigned)__shfl((int)slot, 4 * rn + k); const unsigned char* ep_ = out2 + (size_t)sl_ * DM + 8 * lane;
                    const u32x2 ea_ = *(const u32x2*)ep_, eb_ = *(const u32x2*)(ep_ + 512); ne[k] = (u32x4){ea_.x, ea_.y, eb_.x, eb_.y}; }
            }
            f32x4 v[4];
            unpack8(cx[0], v[0], v[1]); unpack8(cx[1], v[2], v[3]);
#pragma unroll
            for (int q = 0; q < 4; ++q) v[q] = v[q] * DN_ALPHA;
#pragma unroll
            for (int k = 0; k < 4; ++k) { v[0] = v[0] + unpack_fp8x4(ce[k].x); v[1] = v[1] + unpack_fp8x4(ce[k].y); v[2] = v[2] + unpack_fp8x4(ce[k].z); v[3] = v[3] + unpack_fp8x4(ce[k].w); }
            float s = 0.f;
#pragma unroll
            for (int q = 0; q < 4; ++q) s += hsum4(v[q]);
            const float mean = wave_sum(s) * (1.0f / DM); float qq = 0.f;
#pragma unroll
            for (int q = 0; q < 4; ++q) { v[q] = v[q] - mean; qq += hsum4(v[q] * v[q]); }
            const float rstd = 1.0f / sqrtf(wave_sum(qq) * (1.0f / DM) + LN_EPS);
#pragma unroll
            for (int q = 0; q < 4; ++q) v[q] = v[q] * rstd * g4[q] + b4[q];
            bf16* op = xo + (size_t)(row0 + r) * DM + 8 * lane;
            if (!outf) { *(u32x4*)op = pg8::pack8(v[0], v[1]); *(u32x4*)(op + 512) = pg8::pack8(v[2], v[3]); }
            else {
                float* fq_ = outf + (size_t)(row0 + r) * DM + 8 * (lane & ~3) + 4 * (lane & 3);
                const bool odd_ = (lane & 1) != 0;
                *(f32x4*)fq_ = quad_piece<0x50>(v[0], v[1], odd_); *(f32x4*)(fq_ + 16) = quad_piece<0xFA>(v[0], v[1], odd_);
                *(f32x4*)(fq_ + 512) = quad_piece<0x50>(v[2], v[3], odd_); *(f32x4*)(fq_ + 528) = quad_piece<0xFA>(v[2], v[3], odd_); }
            cx[0] = nx[0]; cx[1] = nx[1];
#pragma unroll
            for (int k = 0; k < 4; ++k) ce[k] = ne[k];
        }
    }
}

constexpr int NPHASE = 1 + DEPTH * 9;
__global__ void __launch_bounds__(512, 2) mk_fwd(Args a) {
    extern __shared__ __attribute__((aligned(16))) unsigned char lds_raw[];
    LAS unsigned char* lds = (LAS unsigned char*)lds_raw;
    const int tid = threadIdx.x;
    const int G = gridDim.x, c = blockIdx.x;
    unsigned char* ws = a.ws;
    unsigned* ctl = (unsigned*)(ws + WS_CTL);
    if (tid < 64) ((LAS unsigned*)(lds + MISC_OFF))[tid] = 0u;
    __syncthreads();
    const XcdBarrier bar = xcd_barrier_post(ctl + CW_BAR, (volatile LAS unsigned*)(lds + MISC_OFF) + 8);
    const int lo = a.ph_lo, hi = a.ph_hi;
#ifdef REPEAT_PH
#define REP(k) for (int rep_ = 0; rep_ < (((k) == REPEAT_PH) ? 2 : 1); ++rep_)
#else
#define REP(k)
#endif
#define PSTAMP0(k) do {} while (0)
#define PSTAMP1(k) do {} while (0)
#define IN(k) (lo <= (k) && (k) < hi)
#define BAR_AFTER(k) do { if (hi > (k) + 1) xcd_barrier(bar); PSTAMP1(k); } while (0)
    bf16* xb = (bf16*)(ws + WS_XB); bf16* proj = (bf16*)(ws + WS_PROJ); bf16* yb = (bf16*)(ws + WS_Y); bf16* pre = (bf16*)(ws + WS_PRE);
    unsigned char* out2 = ws + WS_OUT2; bf16* qb = (bf16*)(ws + WS_Q); bf16* kvb = (bf16*)(ws + WS_KV);
    bf16* cqn = (bf16*)(ws + WS_CQN); bf16* ckvn = (bf16*)(ws + WS_CKVN); bf16* krope = (bf16*)(ws + WS_KROPE);
    float* cosT = (float*)(ws + WS_ROPE); float* sinT = cosT + SEQ * 16; float* fb = (float*)(ws + WS_FB); float* fz = (float*)(ws + WS_FZ);
    unsigned* list = (unsigned*)(ws + WS_LIST); float* glist = (float*)(ws + WS_GLIST); unsigned* tokinfo = (unsigned*)(ws + WS_TOKINFO);

#ifndef PHMASK
#define PHMASK 0xFFFF
#endif
#define PHON(j) ((PHMASK >> (j)) & 1)
    if (IN(0)) REP(0) { PSTAMP0(0); if (PHON(15)) prologue_phase(a, lds, G, c); BAR_AFTER(0); }
    for (int L = 0; L < DEPTH; ++L) {
        const int pb = 1 + L * 9; const bool odd = (L & 1) != 0; const int li = L >> 1;
        unsigned* cnt = ctl + CW_CNT + L * NEXP * CNT_STRIDE;
        if (IN(pb + 0)) REP(pb + 0) { PSTAMP0(pb + 0);
            if (!odd) { if (PHON(0)) { pg8::DenseOrder S; S.init(NTOK, EVEN_IN, G, c, xb, (bf16*)(ws + WS_EVIN) + (size_t)li * EVEN_IN * 1024, (size_t)256 * DM * 2, (size_t)256 * 1024 * 2);
                pg8::EpiProjEven E{proj};
                pg8::gemm_phase<pg8::EpiProjEven, pg8::DenseOrder, false, true>(lds, 1024, DM, 1024, S, E, nullptr); } }
            else { if (PHON(9)) { pg8::DenseOrder S; S.init(NTOK, ODD_INP, G, c, xb, (bf16*)(ws + WS_ODIN) + (size_t)li * ODD_INP * 1024, (size_t)256 * DM * 2, (size_t)256 * 1024 * 2);
                pg8::EpiProjOdd E{proj, fz};
                pg8::gemm_phase<pg8::EpiProjOdd, pg8::DenseOrder, false, true>(lds, 1024, DM, 1024, S, E, nullptr); } }
            BAR_AFTER(pb + 0);
        }
        if (IN(pb + 1)) REP(pb + 1) { PSTAMP0(pb + 1);
            if (!odd) { if (PHON(1)) sgu_phase(lds, proj, yb, (const bf16*)(ws + WS_SGUW) + (size_t)li * 8 * 128 * 128, a.in[3] + li * 512, a.in[4] + li * 512, a.in[6] + li * 8 * 128, a.in[2] + li * 3 * 512, G, c); }
            else if (PHON(10)) odd_mid_phase(proj, fz, a.in[13] + li * 8, cqn, ckvn, krope, fb, cosT, sinT, ctl + CW_KMAX + L * 64, G, c);
            BAR_AFTER(pb + 1);
        }
        if (odd) {
            if (IN(pb + 2)) REP(pb + 2) { PSTAMP0(pb + 2); if (PHON(2)) {
                pg8::DenseOrder S; S.init(NTOK, 1792, G, c, cqn, (bf16*)(ws + WS_UQT) + (size_t)li * 768 * 256, (size_t)256 * 256 * 2, (size_t)256 * 256 * 2);
                S.nsplit = 3; S.A2 = (const char*)ckvn; S.B2 = (const char*)((bf16*)(ws + WS_UKVT) + (size_t)li * 1024 * 256);
                pg8::EpiQKV E{qb, kvb, cosT, sinT};
                pg8::gemm_phase<pg8::EpiQKV, pg8::DenseOrder, false, true>(lds, 256, 256, 256, S, E, nullptr); }
                BAR_AFTER(pb + 2);
            }
            if (IN(pb + 3)) REP(pb + 3) { PSTAMP0(pb + 3); if (PHON(3)) attn_phase(lds, qb, kvb, krope, proj, fb, yb, ctl + CW_KMAX + L * 64, ctl + CW_AQ + L * 64
#ifdef REPEAT_PH
                + 16 * rep_
#endif
                ); BAR_AFTER(pb + 3); }
        }
        if (IN(pb + 4)) REP(pb + 4) { PSTAMP0(pb + 4); if (PHON(4)) {
            pg8::DenseOrder S; S.init(NTOK, DM, G, c, yb, (odd ? (bf16*)(ws + WS_ODOUT) : (bf16*)(ws + WS_EVOUT)) + (size_t)li * 1024 * 1024, (size_t)256 * DM * 2, (size_t)256 * 1024 * 2);
            pg8::EpiOutProj E{pre};
            pg8::gemm_phase<pg8::EpiOutProj, pg8::DenseOrder, false, true>(lds, 1024, DM, 1024, S, E, nullptr); }
            BAR_AFTER(pb + 4);
        }
        if (IN(pb + 5)) REP(pb + 5) { PSTAMP0(pb + 5);
#ifdef REPEAT_PH
            if (rep_ == 1) ln1_phase(lds, pre, xb, (bf16*)(ws + WS_OUT2), (bf16*)(ws + WS_OUT2 + 128 * MiB), ws + WS_OUT2 + 64 * MiB, a.in[15] + L * DM, a.in[16] + L * DM, (const bf16*)(ws + WS_WRT) + (size_t)L * 2 * NEXP * DM, a.in[20] + L * NEXP, ctl + CW_CNT + 4 * NEXP * CNT_STRIDE, (unsigned*)(ws + WS_OUT2 + 96 * MiB), (float*)(ws + WS_OUT2 + 100 * MiB), (unsigned*)(ws + WS_OUT2 + 104 * MiB), G, c); else
#endif
            if (PHON(5)) ln1_phase(lds, pre, xb, xb, (bf16*)(ws + WS_XL), ws + WS_X8, a.in[15] + L * DM, a.in[16] + L * DM, (const bf16*)(ws + WS_WRT) + (size_t)L * 2 * NEXP * DM, a.in[20] + L * NEXP, cnt, list, glist, tokinfo, G, c);
            BAR_AFTER(pb + 5);
        }
        if (IN(pb + 6)) REP(pb + 6) { PSTAMP0(pb + 6); if (PHON(6)) {
            pg8::MoeOrder S; S.init((LAS unsigned*)(lds + MISC_OFF - 512), cnt, 8, G, c, ws + WS_X8, ws + WS_W1T + (size_t)L * NEXP * 2048 * 1024, (size_t)2048 * 1024, (size_t)256 * 1024, (size_t)DM, true);
            pg8::EpiSwiGLU E{ws + WS_H, (const float*)(ws + WS_B1P) + (size_t)L * NEXP * 2048};
            pg8::gemm_phase<pg8::EpiSwiGLU, pg8::MoeOrder, true, true, true>(lds, 1024, DM, 1024, S, E, list); }
            BAR_AFTER(pb + 6);
        }
        if (IN(pb + 7)) REP(pb + 7) { PSTAMP0(pb + 7); if (PHON(7)) {
            pg8::MoeOrder S; S.init((LAS unsigned*)(lds + MISC_OFF - 512), cnt, 4, G, c, ws + WS_H, ws + WS_W2T + (size_t)L * NEXP * 1024 * 1024, (size_t)1024 * 1024, (size_t)256 * 1024, (size_t)DFF, false);
            pg8::EpiMoeOut E{out2, a.in[24] + (size_t)L * NEXP * DM, glist};
            pg8::gemm_phase<pg8::EpiMoeOut, pg8::MoeOrder, false, true, true>(lds, 1024, DFF, 1024, S, E, nullptr); }
            BAR_AFTER(pb + 7);
        }
        if (IN(pb + 8)) REP(pb + 8) { PSTAMP0(pb + 8);
#ifdef REPEAT_PH
            if (rep_ == 1) ln2_phase(out2, xb, (bf16*)(ws + WS_H), a.in[17] + L * DM, a.in[18] + L * DM, cnt, tokinfo, nullptr, G, c); else
#endif
            if (PHON(8)) ln2_phase(out2, xb, xb, a.in[17] + L * DM, a.in[18] + L * DM, cnt, tokinfo, (L == DEPTH - 1) ? a.out : nullptr, G, c);
            BAR_AFTER(pb + 8);
        }
    }
#undef IN
#undef BAR_AFTER
}

extern "C" void kernel_launch(void* const* d_in, const int* in_sizes, int n_in, void* d_out, int out_size, void* d_ws, size_t ws_size, hipStream_t stream) {
    static int grid = 0;
    if (grid == 0) {
        if (n_in != 25 || out_size != NTOK * DM || ws_size < WS_END) { fprintf(stderr, "kernel_launch: unexpected problem (n_in %d out %d ws %zu)\n", n_in, out_size, ws_size); grid = -1; return; }
        int dev = 0, cus = 0, per_cu = 0;
        if (hipGetDevice(&dev) != hipSuccess || hipDeviceGetAttribute(&cus, hipDeviceAttributeMultiprocessorCount, dev) != hipSuccess) { grid = -1; return; }
        if (hipFuncSetAttribute((const void*)mk_fwd, hipFuncAttributeMaxDynamicSharedMemorySize, LDS_BYTES) != hipSuccess) { fprintf(stderr, "kernel_launch: hipFuncSetAttribute failed\n"); grid = -1; return; }
        if (hipOccupancyMaxActiveBlocksPerMultiprocessor(&per_cu, (const void*)mk_fwd, 512, LDS_BYTES) != hipSuccess || per_cu < 1) { fprintf(stderr, "kernel_launch: occupancy query says %d\n", per_cu); }
        (void)hipGetLastError();
        grid = cus;
    }
    if (grid < 0) return;
    hipMemsetAsync((char*)d_ws + WS_CTL, 0, CTL_ZERO_BYTES, stream);
    Args a{};
    for (int i = 0; i < 25; ++i) a.in[i] = (const float*)d_in[i];
    a.out = (float*)d_out; a.ws = (unsigned char*)d_ws;
#ifndef MK_PER_PHASE
    a.ph_lo = 0; a.ph_hi = NPHASE;
    hipLaunchKernelGGL(mk_fwd, dim3(grid), dim3(512), LDS_BYTES, stream, a);
#else
    for (int p = 0; p < NPHASE; ++p) { a.ph_lo = p; a.ph_hi = p + 1; hipLaunchKernelGGL(mk_fwd, dim3(grid), dim3(512), LDS_BYTES, stream, a); }
#endif
}
```

```cpp
#include <hip/hip_runtime.h>
#include <cstdio>
#include <cstdint>

#define LAS __attribute__((address_space(3)))
#define GAS __attribute__((address_space(1)))
typedef unsigned short bf16;
typedef short bf16x8 __attribute__((ext_vector_type(8)));
typedef short s16x4 __attribute__((ext_vector_type(4)));
typedef float f32x2 __attribute__((ext_vector_type(2)));
typedef float f32x4 __attribute__((ext_vector_type(4)));
typedef float f32x16 __attribute__((ext_vector_type(16)));
typedef unsigned u32x2 __attribute__((ext_vector_type(2)));
typedef unsigned u32x4 __attribute__((ext_vector_type(4)));
typedef int i32x8 __attribute__((ext_vector_type(8)));

constexpr int NTOK = 32768, DM = 1024, SEQ = 4096, NBATCH = 8, DEPTH = 4;
constexpr int EVEN_IN = 2560, ODD_IN = 1960, ODD_INP = 2048;
constexpr int ODD_LD = 2112;
constexpr int NEXP = 32, TOPK = 4, DFF = 1024, CAP = 32768;
constexpr int HROWS = NTOK * TOPK + NEXP * 256;
constexpr float DN_ALPHA = 1.681792830507429f;
constexpr float LN_EPS = 1e-5f;
constexpr float LOG2E = 1.4426950408889634f;
constexpr float MLA_QS = 0.10206207261596575f * LOG2E;
constexpr float FOX_QS = 0.125f * LOG2E;

constexpr size_t MiB = 1u << 20;
constexpr size_t WS_CTL = 0, CTL_ZERO_BYTES = 160 * 1024;
constexpr size_t WS_ROPE = 1 * MiB;
constexpr size_t WS_WRT = 2 * MiB;
constexpr size_t WS_B1P = 3 * MiB;
constexpr size_t WS_SGUW = 4 * MiB;
constexpr size_t WS_FB = 5 * MiB;
constexpr size_t WS_FZ = 6 * MiB;
constexpr size_t WS_TOKINFO = 7 * MiB;
constexpr size_t WS_KROPE = 8 * MiB;
constexpr size_t WS_LIST = 10 * MiB;
constexpr size_t WS_GLIST = 14 * MiB;
constexpr size_t WS_UQT = 18 * MiB;
constexpr size_t WS_UKVT = 19 * MiB;
constexpr size_t WS_EVIN = 20 * MiB;
constexpr size_t WS_EVOUT = 30 * MiB;
constexpr size_t WS_ODIN = 34 * MiB;
constexpr size_t WS_ODOUT = 42 * MiB;
constexpr size_t WS_W1T = 64 * MiB;
constexpr size_t WS_W2T = 576 * MiB;
constexpr size_t WS_XB = 832 * MiB;
constexpr size_t WS_PROJ = 896 * MiB;
constexpr size_t WS_Y = 1056 * MiB;
constexpr size_t WS_PRE = 1120 * MiB;
constexpr size_t WS_H = 1248 * MiB;
constexpr size_t WS_OUT2 = 1520 * MiB;
constexpr size_t WS_Q = 1792 * MiB;
constexpr size_t WS_KV = 1840 * MiB;
constexpr size_t WS_CQN = 1904 * MiB;
constexpr size_t WS_CKVN = 1920 * MiB;
constexpr size_t WS_X8 = 1936 * MiB;
constexpr size_t WS_XL = 1968 * MiB;
constexpr size_t WS_END = 2032 * MiB;
static_assert(WS_H + (size_t)HROWS * 2048 <= WS_OUT2 && WS_OUT2 + (size_t)HROWS * 2048 <= WS_Q, "ws map");
constexpr int CW_BAR = 4096;
constexpr int CW_CNT = 16384;
constexpr int CNT_STRIDE = 64;
constexpr int CW_AQ = 36864;
constexpr int CW_KMAX = 32768;
constexpr int LDS_BYTES = 163840;
constexpr int EPI_LDS_OFF = 139264;
constexpr int MISC_OFF = LDS_BYTES - 256;

__device__ __forceinline__ float bf2f(unsigned b) { return __uint_as_float(b << 16); }
__device__ __forceinline__ unsigned f2bf(float f) { unsigned u = __float_as_uint(f); return (u + 0x7fffu + ((u >> 16) & 1u)) >> 16; }
__device__ __forceinline__ unsigned cvt_pk_bf16(float lo, float hi) { unsigned r; asm volatile("v_cvt_pk_bf16_f32 %0, %1, %2" : "=v"(r) : "v"(lo), "v"(hi)); return r; }
__device__ __forceinline__ float wave_sum(float v) {
    v += __builtin_bit_cast(float, __builtin_amdgcn_update_dpp(0, __builtin_bit_cast(int, v), 0xB1, 0xF, 0xF, true));
    v += __builtin_bit_cast(float, __builtin_amdgcn_update_dpp(0, __builtin_bit_cast(int, v), 0x4E, 0xF, 0xF, true));
    v += __builtin_bit_cast(float, __builtin_amdgcn_update_dpp(0, __builtin_bit_cast(int, v), 0x141, 0xF, 0xF, true));
    v += __builtin_bit_cast(float, __builtin_amdgcn_update_dpp(0, __builtin_bit_cast(int, v), 0x140, 0xF, 0xF, true));
    { auto rr = __builtin_amdgcn_permlane16_swap(__float_as_uint(v), __float_as_uint(v), false, false); v = __uint_as_float(rr[0]) + __uint_as_float(rr[1]); }
    { auto rr = __builtin_amdgcn_permlane32_swap(__float_as_uint(v), __float_as_uint(v), false, false); v = __uint_as_float(rr[0]) + __uint_as_float(rr[1]); }
    return v;
}
template <int CTRL> __device__ __forceinline__ float dpp_f(float x) { return __builtin_bit_cast(float, __builtin_amdgcn_update_dpp(0, __builtin_bit_cast(int, x), CTRL, 0xF, 0xF, true)); }
template <int CTRL> __device__ __forceinline__ f32x4 quad_piece(f32x4 a, f32x4 b, bool odd) {
    const float ax = dpp_f<CTRL>(a.x), ay = dpp_f<CTRL>(a.y), az = dpp_f<CTRL>(a.z), aw = dpp_f<CTRL>(a.w), bx = dpp_f<CTRL>(b.x), by = dpp_f<CTRL>(b.y), bz = dpp_f<CTRL>(b.z), bw = dpp_f<CTRL>(b.w);
    f32x4 r; r.x = odd ? bx : ax; r.y = odd ? by : ay; r.z = odd ? bz : az; r.w = odd ? bw : aw;
    return r;
}
__device__ __forceinline__ float gelu_tanh(float x) {
    const float u = 0.7978845608028654f * (x + 0.044715f * x * x * x);
    return x * __builtin_amdgcn_rcpf(1.0f + __builtin_amdgcn_exp2f(-2.0f * LOG2E * u));
}

#define XB_TMO      128
#define XB_XCNT(j)  (256  + 64 * (j))
#define XB_XSUB(j)  (1280 + 64 * (j))
#define XB_XGEN(j)  (2304 + 64 * (j))
#define XB_TOP      3328
#define XB_TOPGEN   3392
#define XCD_BAR_WORDS 3456
#define XB_SPIN_CAP (1u << 18)

__device__ __forceinline__ unsigned xb_ld(unsigned* p)              { return __hip_atomic_load(p, __ATOMIC_RELAXED, __HIP_MEMORY_SCOPE_AGENT); }
__device__ __forceinline__ unsigned xb_add(unsigned* p, unsigned v) { return __hip_atomic_fetch_add(p, v, __ATOMIC_RELAXED, __HIP_MEMORY_SCOPE_AGENT); }
__device__ __forceinline__ unsigned xb_xcc_id() { return (unsigned)__builtin_amdgcn_s_getreg((3 << 11) | 20) & 0xFu; }
#define XB_SPIN(cond, bar) do { unsigned _sp = 0; while (cond) { __builtin_amdgcn_s_sleep(1); \
    if ((++_sp & 255u) == 0u) { if (xb_ld(&(bar)[XB_TMO])) break; if (_sp > XB_SPIN_CAP) { atomicAdd(&(bar)[XB_TMO], 1u); break; } } } } while (0)

struct XcdBarrier { unsigned* bar; unsigned x; volatile LAS unsigned* st; };

__device__ __forceinline__ XcdBarrier xcd_barrier_post(unsigned* bar, volatile LAS unsigned* st) {
    XcdBarrier b; b.bar = bar; b.x = xb_xcc_id(); b.st = st;
    if (threadIdx.x == 0) (void)xb_add(&bar[XB_XCNT(b.x)], 1u);
    return b;
}
__device__ __forceinline__ void xcd_barrier_complete(unsigned* bar, unsigned x, unsigned& nloc, unsigned& nx) {
    const unsigned G = gridDim.x * gridDim.y * gridDim.z;
    unsigned sum, cnt, mine, sp = 0u;
    for (;;) {
        sum = 0u; cnt = 0u; mine = 0u;
#pragma unroll
        for (unsigned j = 0; j < 16; ++j) { const unsigned c = xb_ld(&bar[XB_XCNT(j)]); sum += c; cnt += (c > 0u) ? 1u : 0u; mine = (j == x) ? c : mine; }
        if (sum == G) break;
        __builtin_amdgcn_s_sleep(1);
        if ((++sp & 255u) == 0u) { if (xb_ld(&bar[XB_TMO])) break; if (sp > XB_SPIN_CAP) { atomicAdd(&bar[XB_TMO], 1u); break; } }
    }
    nloc = mine > 0u ? mine : 1u; nx = cnt > 0u ? cnt : 1u;
}
__device__ __forceinline__ void xcd_barrier(const XcdBarrier& b) {
    asm volatile("s_waitcnt vmcnt(0)" ::: "memory");
    __syncthreads();
    if (threadIdx.x == 0) {
        unsigned* bar = b.bar;
        __builtin_amdgcn_s_waitcnt(0);
        unsigned nloc = b.st[0], nx = b.st[1];
        if (nloc == 0u) { xcd_barrier_complete(bar, b.x, nloc, nx); b.st[0] = nloc; b.st[1] = nx; }
        const unsigned old = xb_add(&bar[XB_XSUB(b.x)], 1u);
        const unsigned gen = old / nloc;
        if (old + 1u == (gen + 1u) * nloc) {
            __builtin_amdgcn_fence(__ATOMIC_RELEASE, "agent");
            asm volatile("s_waitcnt vmcnt(0)" ::: "memory");
            const unsigned og = xb_add(&bar[XB_TOP], 1u);
            const unsigned tg = og / nx;
            if (og + 1u == (tg + 1u) * nx) xb_add(&bar[XB_TOPGEN], 1u);
            else XB_SPIN(xb_ld(&bar[XB_TOPGEN]) == tg, bar);
            __builtin_amdgcn_fence(__ATOMIC_ACQUIRE, "agent");
            xb_add(&bar[XB_XGEN(b.x)], 1u);
            asm volatile("s_waitcnt vmcnt(0)" ::: "memory");
        } else {
            XB_SPIN(xb_ld(&bar[XB_XGEN(b.x)]) == gen, bar);
            __builtin_amdgcn_fence(__ATOMIC_ACQUIRE, "agent");
            asm volatile("s_waitcnt vmcnt(0)" ::: "memory");
        }
    }
    __syncthreads();
}

namespace pg8 {
constexpr int BM = 256, BK = 64, HALF = 128, HTB = HALF * BK * 2, STAGE_BYTES = 8 * HTB, NXCD = 8, WGM = 8;
__host__ __device__ __forceinline__ int lds_byte(int r, int c) { const int st = (r >> 4) * 2 + (c >> 5), rr = r & 15, cc = c & 31, ob = rr * 64 + cc * 2; return st * 1024 + (ob ^ (((ob >> 9) & 1) << 5)); }
__host__ __device__ __forceinline__ void stage_rc(int b, int& R, int& C) { const int st = b / 1024, sb = b % 1024, swz = sb ^ (((sb >> 9) & 1) << 5); R = (st >> 1) * 16 + swz / 64; C = (st & 1) * 32 + (swz % 64) / 2; }
__host__ __device__ __forceinline__ int lds_byte8(int r, int cb) { const int st = (r >> 4) * 2 + (cb >> 6), rr = r & 15, ob = rr * 64 + (cb & 63); return st * 1024 + (ob ^ (((ob >> 9) & 1) << 4)); }
__host__ __device__ __forceinline__ void stage_rc8(int b, int& R, int& CB) { const int st = b / 1024, sb = b % 1024, swz = sb ^ (((sb >> 9) & 1) << 4); R = (st >> 1) * 16 + swz / 64; CB = (st & 1) * 64 + (swz % 64); }
__host__ __device__ __forceinline__ int perm32(int rho) { const int n = rho >> 4, i = rho & 15; return 8 * (i >> 2) + 4 * n + (i & 3); }

struct GUnit { const char* A; const char* B; int row0, col0, nvalid, e, lrow0, pad; };

struct DenseOrder {
    int nM, nN, nwg, G, c, nsplit; const char* A; const char* B; const char* A2; const char* B2; size_t astep, bstep;
    __device__ __forceinline__ void init(int M, int N, int G_, int c_, const void* A_, const void* B_, size_t astep_, size_t bstep_) {
        nM = M / BM; nN = N / BM; nwg = nM * nN; G = G_; c = c_; nsplit = nN; A = (const char*)A_; B = (const char*)B_; A2 = A; B2 = B; astep = astep_; bstep = bstep_; }
    __device__ __forceinline__ bool next(int i, GUnit& u) const {
        const long L = (long)i * G + c; if (L >= nwg) return false;
        int wgid = (int)L; { const int q = nwg / NXCD, r = nwg % NXCD, xcd = wgid % NXCD, off = wgid / NXCD; wgid = (xcd < r ? xcd * (q + 1) : r * (q + 1) + (xcd - r) * q) + off; }
        const int nig = WGM * nN, gid = wgid / nig, fm = gid * WGM, gsz = (nM - fm) < WGM ? (nM - fm) : WGM;
        const int pm = fm + ((wgid % nig) % gsz), pn = (wgid % nig) / gsz;
        if (pn < nsplit) { u.A = A + (size_t)pm * astep; u.B = B + (size_t)pn * bstep; } else { u.A = A2 + (size_t)pm * astep; u.B = B2 + (size_t)(pn - nsplit) * bstep; }
        u.row0 = pm * BM; u.col0 = pn * BM; u.nvalid = BM; u.e = 0; u.lrow0 = 0; u.pad = 0; return true;
    }
};
struct MoeOrder {
    int G, c, NT, total; LAS unsigned* tab; const char* Abase; const char* Bbase; size_t bexp, btile, arow; bool gather;
    __device__ __forceinline__ void init(LAS unsigned* tab_, const unsigned* counts, int NT_, int G_, int c_, const void* A_, const void* B_, size_t bexp_, size_t btile_, size_t arow_, bool gather_) {
        int t_ = threadIdx.x; asm volatile("" : "+v"(t_)); const int lane = t_ & 63;
        G = G_; c = c_; NT = NT_; tab = tab_; Abase = (const char*)A_; Bbase = (const char*)B_; bexp = bexp_; btile = btile_; arow = arow_; gather = gather_;
        const unsigned cnt = (lane < NEXP) ? __hip_atomic_load(counts + lane * CNT_STRIDE, __ATOMIC_RELAXED, __HIP_MEMORY_SCOPE_AGENT) : 0u;
        const unsigned mt = (cnt + 255u) >> 8;
        unsigned incl = mt;
#pragma unroll
        for (int o = 1; o < 64; o <<= 1) { const unsigned t = __shfl_up(incl, o); if (lane >= o) incl += t; }
        const unsigned excl = incl - mt;
        if (t_ < NEXP) { tab[lane] = cnt; tab[32 + lane] = excl * 256u; tab[64 + lane] = excl * (unsigned)NT; }
        total = (int)__builtin_amdgcn_readlane((int)incl, 63) * NT;
        __syncthreads();
    }
    __device__ __forceinline__ bool next(int i, GUnit& u) const {
        long L;
        if ((G & 7) == 0) { const int x = c & 7, q = c >> 3, ux = i * (G >> 3) + q, pl = ux / NT, ntl = ux - pl * NT; const long pair = (long)pl * 8 + x; if (pair * NT >= total) return false; L = pair * NT + ntl; }
        else { L = (long)i * G + c; if (L >= total) return false; }
        int t_ = threadIdx.x; asm volatile("" : "+v"(t_)); const int lane = t_ & 63;
        const unsigned us_l = tab[64 + (lane & 31)];
        const unsigned long long m = __ballot(lane < NEXP && us_l <= (unsigned)L);
        const int e = __builtin_amdgcn_readfirstlane(__popcll(m) - 1);
        const unsigned us = (unsigned)__builtin_amdgcn_readfirstlane((int)tab[64 + e]), ce = (unsigned)__builtin_amdgcn_readfirstlane((int)tab[e]), oe = (unsigned)__builtin_amdgcn_readfirstlane((int)tab[32 + e]);
        const int local = (int)((unsigned)L - us), mt = local / NT, nt = local - mt * NT;
        u.row0 = (int)oe + mt * 256; u.col0 = nt * 256; u.nvalid = (int)ce - mt * 256; if (u.nvalid > 256) u.nvalid = 256; u.e = e; u.lrow0 = e * CAP + mt * 256; u.pad = 0;
        u.A = gather ? Abase : Abase + (size_t)u.row0 * arow;
        u.B = Bbase + (size_t)e * bexp + (size_t)nt * btile;
        return true;
    }
};

template <class Epi, class Sched, bool GATHER, bool ALIGN_EPI, bool FP8 = false>
__device__ __forceinline__ void gemm_phase(LAS unsigned char* lds, const int K, const int lda, const int ldb, const Sched& S, const Epi& E, const unsigned* list) {
    constexpr int ES = FP8 ? 1 : 2;
    int tid_ = threadIdx.x; asm volatile("" : "+v"(tid_));
    const int tid = tid_, wid = __builtin_amdgcn_readfirstlane(tid >> 6), lane = tid & 63, wr = wid >> 2, wc = wid & 3, fr = lane & 15, fq = lane >> 4;
#ifdef PROBE_KDOUBLE
    constexpr bool KD = FP8 && GATHER;
#else
    constexpr bool KD = false;
#endif
    const int nt0 = K * ES / (BK * 2), nt = KD ? 2 * nt0 : nt0;
#ifndef STAGGER_OFF
    { const int q_ = (S.c >> 3) & 31; for (int k_ = 0; k_ < q_; ++k_) __builtin_amdgcn_s_sleep(0); }
#endif
    __builtin_amdgcn_s_waitcnt(0x0F70);
#define KW(t_) ((size_t)(KD ? ((t_) & (nt0 - 1)) : (t_)))
    unsigned voffB[2];
#pragma unroll
    for (int i = 0; i < 2; ++i) { int R, C; if constexpr (FP8) { stage_rc8(tid * 16 + i * 8192, R, C); } else { stage_rc(tid * 16 + i * 8192, R, C); C *= 2; }
        const int Rb = Epi::ADJ ? ((R >> 5) * 64 + 16 * ((R & 15) >> 2) + 4 * ((R >> 4) & 1) + (R & 3)) : ((R & ~31) + perm32(R & 31));
        voffB[i] = (unsigned)(Rb * ldb * ES + C); }
    const size_t kstep = (size_t)(BK * 2);
    const size_t hstepB = (size_t)(Epi::ADJ ? 8 : HALF) * ldb * ES;
    const unsigned rowb = (unsigned)lda * (unsigned)ES;
    const unsigned ldsw = (unsigned)wid * 1024u;
    const int aoff = FP8 ? lds_byte8(wr * 64 + fr, fq * 32) : lds_byte(wr * 64 + fr, fq * 8), boff = FP8 ? lds_byte8(wc * 32 + fr, fq * 32) : lds_byte(wc * 32 + fr, fq * 8);
#define PG8_SA(b, h) (((b) * 2 + (h)) * HTB)
#define PG8_SB(b, h) ((4 + (b) * 2 + (h)) * HTB)
#define PG8_GL(bufoff, gptr, i_) __builtin_amdgcn_global_load_lds((const unsigned*)(gptr), (LAS unsigned*)(lds + (bufoff) + ldsw + (i_) * 8192), 16, 0, 0)
#define PG8_OPQ(x) ({ unsigned o_ = (x); asm volatile("" : "+v"(o_)); o_; })
#define PG8_STAGE_B(bufoff, gbase) do { PG8_GL(bufoff, (const char*)(gbase) + PG8_OPQ(voffB[0]), 0); PG8_GL(bufoff, (const char*)(gbase) + PG8_OPQ(voffB[1]), 1); } while (0)
#define PG8_STAGE_A(bufoff, gbase, o0, o1) do { PG8_GL(bufoff, (const char*)(gbase) + PG8_OPQ(o0), 0); PG8_GL(bufoff, (const char*)(gbase) + PG8_OPQ(o1), 1); } while (0)
    constexpr int KOFF = FP8 ? 16 : 1024;
#define aoff1 (FP8 ? (aoff ^ 16) : (aoff + 1024))
#define boff1 (FP8 ? (boff ^ 16) : (boff + 1024))
#define PG8_LD8(addr0, addr1) __builtin_bit_cast(i32x8, __builtin_shufflevector(*(const LAS bf16x8*)(addr0), *(const LAS bf16x8*)(addr1), 0, 1, 2, 3, 4, 5, 6, 7, 8, 9, 10, 11, 12, 13, 14, 15))
#define PG8_LDA(dst, b, h) do { _Pragma("unroll") for (int m = 0; m < 4; ++m) { if constexpr (FP8) dst##8[m] = PG8_LD8(lds + PG8_SA(b, h) + aoff + m * 2048, lds + PG8_SA(b, h) + aoff1 + m * 2048); \
        else { dst[m][0] = *(const LAS bf16x8*)(lds + PG8_SA(b, h) + aoff + m * 2048); dst[m][1] = *(const LAS bf16x8*)(lds + PG8_SA(b, h) + aoff1 + m * 2048); } } } while (0)
#define PG8_LDB(dst, b, h) do { _Pragma("unroll") for (int n = 0; n < 2; ++n) { if constexpr (FP8) dst##8[n] = PG8_LD8(lds + PG8_SB(b, h) + boff + n * 2048, lds + PG8_SB(b, h) + boff1 + n * 2048); \
        else { dst[n][0] = *(const LAS bf16x8*)(lds + PG8_SB(b, h) + boff + n * 2048); dst[n][1] = *(const LAS bf16x8*)(lds + PG8_SB(b, h) + boff1 + n * 2048); } } } while (0)
#define PG8_MMA(ai, bj, At, Bt) do { __builtin_amdgcn_s_setprio(1); _Pragma("unroll") for (int m = 0; m < 4; ++m) _Pragma("unroll") for (int n = 0; n < 2; ++n) { \
        if constexpr (FP8) asm volatile("v_mfma_f32_16x16x128_f8f6f4 %0, %1, %2, %0" : "+v"(acc[ai][bj][m][n]) : "v"(Bt##8[n]), "v"(At##8[m]));     \
        else { _Pragma("unroll") for (int k = 0; k < 2; ++k) acc[ai][bj][m][n] = __builtin_amdgcn_mfma_f32_16x16x32_bf16(Bt[n][k], At[m][k], acc[ai][bj][m][n], 0, 0, 0); } } __builtin_amdgcn_s_setprio(0); } while (0)
#define PG8_WAIT_V(n) asm volatile("s_waitcnt vmcnt(" #n ")" ::: "memory")
#define PG8_WAIT_L(n) asm volatile("s_waitcnt lgkmcnt(" #n ")" ::: "memory")
#define PG8_BAR __builtin_amdgcn_s_barrier()
#define PG8_SCHED __builtin_amdgcn_sched_barrier(0)
#define PG8_AOFFS(dst, u) do { int t2_ = threadIdx.x; asm volatile("" : "+v"(t2_)); unsigned raw_[2][2]; int cb_[2]; \
        _Pragma("unroll") for (int i_ = 0; i_ < 2; ++i_) { int R_, C_; if constexpr (FP8) { stage_rc8(t2_ * 16 + i_ * 8192, R_, C_); C_ >>= 1; } else stage_rc(t2_ * 16 + i_ * 8192, R_, C_); cb_[i_] = C_; \
        _Pragma("unroll") for (int h_ = 0; h_ < 2; ++h_) { const int r_ = h_ * HALF + R_; \
        if constexpr (GATHER) raw_[h_][i_] = list[(u).lrow0 + min(r_, (u).nvalid - 1)]; else raw_[h_][i_] = (unsigned)r_ << 2; } } \
        _Pragma("unroll") for (int i_ = 0; i_ < 2; ++i_) _Pragma("unroll") for (int h_ = 0; h_ < 2; ++h_) dst[h_][i_] = (raw_[h_][i_] >> 2) * rowb + (unsigned)cb_[i_] * 2u; } while (0)
    GUnit cur, nxt; int ui = 0;
    if (!S.next(0, cur)) return;
    f32x4 acc[2][2][4][2];
#pragma unroll
    for (int a = 0; a < 2; ++a)
#pragma unroll
        for (int b = 0; b < 2; ++b)
#pragma unroll
            for (int m = 0; m < 4; ++m)
#pragma unroll
                for (int n = 0; n < 2; ++n) acc[a][b][m][n] = (f32x4){0.f, 0.f, 0.f, 0.f};
    bf16x8 At[4][2], B0[2][2], B1[2][2]; i32x8 At8[4], B08[2], B18[2];
    unsigned cv[2][2], nv[2][2];
    PG8_AOFFS(cv, cur);
    const char* cA = cur.A; const char* cB = cur.B;
    E.prefetch(lds, cur, wid);
    PG8_STAGE_B(PG8_SB(0, 0), cB); PG8_STAGE_B(PG8_SB(0, 1), cB + hstepB); PG8_STAGE_A(PG8_SA(0, 0), cA, cv[0][0], cv[0][1]); PG8_STAGE_A(PG8_SA(0, 1), cA, cv[1][0], cv[1][1]);
    if (wr == 1) PG8_BAR;
    PG8_WAIT_V(2); PG8_BAR;
    PG8_STAGE_B(PG8_SB(1, 0), cB + kstep); PG8_STAGE_A(PG8_SA(1, 0), cA + kstep, cv[0][0], cv[0][1]); PG8_STAGE_B(PG8_SB(1, 1), cB + hstepB + kstep);
    PG8_WAIT_V(6); PG8_BAR;
    for (;;) {
        const bool has_next = S.next(ui + 1, nxt);
        const char* nA = has_next ? nxt.A : cA; const char* nB = has_next ? nxt.B : cB;
        if constexpr (GATHER) {
            int t2_ = threadIdx.x; asm volatile("" : "+v"(t2_));
#pragma unroll
            for (int i_ = 0; i_ < 2; ++i_) { int R_, C_; if constexpr (FP8) { stage_rc8(t2_ * 16 + i_ * 8192, R_, C_); } else stage_rc(t2_ * 16 + i_ * 8192, R_, C_);
#pragma unroll
                for (int h_ = 0; h_ < 2; ++h_) { const int r_ = h_ * HALF + R_; const unsigned* lp_ = list + (has_next ? nxt.lrow0 + min(r_, nxt.nvalid - 1) : cur.lrow0);
                    __builtin_amdgcn_global_load_lds(lp_, (LAS unsigned*)(lds + EPI_LDS_OFF + wid * 2048 + 1024 + (h_ * 2 + i_) * 256), 4, 0, 0); } }
        }
#pragma unroll 1
        for (int t = 0; t < nt; t += 2) {
            const bool last = (t == nt - 2);
            const char* a1 = cA + KW(t + 1) * kstep;
            const char* a2 = last ? nA : cA + KW(t + 2) * kstep; const char* b2 = last ? nB : cB + KW(t + 2) * kstep;
            const char* a3 = a2 + kstep; const char* b3 = b2 + kstep;
            if constexpr (GATHER) { if (last && has_next) { int t4_ = threadIdx.x; asm volatile("" : "+v"(t4_));
#pragma unroll
                for (int i_ = 0; i_ < 2; ++i_) { int R_, C_; if constexpr (FP8) { stage_rc8(t4_ * 16 + i_ * 8192, R_, C_); } else { stage_rc(t4_ * 16 + i_ * 8192, R_, C_); C_ *= 2; }
                    const float w_ = *(const LAS float*)(lds + EPI_LDS_OFF + wid * 2048 + 1024 + i_ * 256 + (t4_ & 63) * 4); cv[0][i_] = (__float_as_uint(w_) >> 2) * rowb + (unsigned)C_; } } }
            PG8_LDB(B0, 0, 0); PG8_LDB(B1, 0, 1); PG8_SCHED; PG8_LDA(At, 0, 0); PG8_STAGE_A(PG8_SA(1, 1), a1, cv[1][0], cv[1][1]);
            if constexpr (GATHER) { if (last && has_next) { int t4_ = threadIdx.x; asm volatile("" : "+v"(t4_));
#pragma unroll
                for (int i_ = 0; i_ < 2; ++i_) { int R_, C_; if constexpr (FP8) { stage_rc8(t4_ * 16 + i_ * 8192, R_, C_); } else { stage_rc(t4_ * 16 + i_ * 8192, R_, C_); C_ *= 2; }
                    const float w_ = *(const LAS float*)(lds + EPI_LDS_OFF + wid * 2048 + 1024 + (2 + i_) * 256 + (t4_ & 63) * 4); cv[1][i_] = (__float_as_uint(w_) >> 2) * rowb + (unsigned)C_; } } }
            PG8_WAIT_V(8); PG8_WAIT_L(0); PG8_BAR; PG8_MMA(0, 0, At, B0); PG8_MMA(0, 1, At, B1); PG8_BAR; PG8_SCHED;
            PG8_LDA(At, 0, 1); PG8_STAGE_B(PG8_SB(0, 0), b2); PG8_STAGE_B(PG8_SB(0, 1), b2 + hstepB); PG8_STAGE_A(PG8_SA(0, 0), a2, cv[0][0], cv[0][1]);
            PG8_WAIT_V(8); PG8_WAIT_L(0); PG8_BAR; PG8_MMA(1, 0, At, B0); PG8_MMA(1, 1, At, B1); PG8_BAR; PG8_SCHED;
            PG8_LDB(B0, 1, 0); PG8_LDB(B1, 1, 1); PG8_SCHED; PG8_LDA(At, 1, 0); PG8_STAGE_A(PG8_SA(0, 1), a2, cv[1][0], cv[1][1]);
            PG8_WAIT_V(8); PG8_WAIT_L(0); PG8_BAR; PG8_MMA(0, 0, At, B0); PG8_MMA(0, 1, At, B1); PG8_BAR; PG8_SCHED;
            PG8_LDA(At, 1, 1); PG8_STAGE_B(PG8_SB(1, 0), b3); PG8_STAGE_B(PG8_SB(1, 1), b3 + hstepB); PG8_STAGE_A(PG8_SA(1, 0), a3, cv[0][0], cv[0][1]);
            PG8_WAIT_V(8); PG8_WAIT_L(0); PG8_BAR; PG8_MMA(1, 0, At, B0); PG8_MMA(1, 1, At, B1); PG8_BAR; PG8_SCHED;
        }
        if constexpr (ALIGN_EPI) { if (wr == 0) PG8_BAR; }
        if constexpr (FP8) asm volatile("s_nop 15\n\ts_nop 7" ::: "memory");
        { int t3_ = threadIdx.x; asm volatile("" : "+v"(t3_)); E(acc, cur, wr, wc, t3_ & 15, (t3_ >> 4) & 3, lds, wid); }
        if (!has_next) break;
#pragma unroll
        for (int a = 0; a < 2; ++a)
#pragma unroll
            for (int b = 0; b < 2; ++b)
#pragma unroll
                for (int m = 0; m < 4; ++m)
#pragma unroll
                    for (int n = 0; n < 2; ++n) acc[a][b][m][n] = (f32x4){0.f, 0.f, 0.f, 0.f};
        cur = nxt; cA = nA; cB = nB; ++ui;
        E.prefetch(lds, cur, wid);
        if constexpr (ALIGN_EPI) { if (wr == 1) PG8_BAR; }
    }
    PG8_WAIT_V(0);
    if constexpr (!ALIGN_EPI) { if (wr == 0) PG8_BAR; }
    PG8_BAR;
#undef PG8_SA
#undef PG8_SB
#undef PG8_GL
#undef PG8_STAGE_A
#undef PG8_OPQ
#undef PG8_STAGE_B
#undef PG8_LDA
#undef PG8_LDB
#undef PG8_MMA
#undef PG8_LD8
#undef aoff1
#undef boff1
#undef PG8_WAIT_V
#undef PG8_WAIT_L
#undef PG8_BAR
#undef PG8_SCHED
#undef PG8_AOFFS
#undef KW
}
}

namespace pg8 {
typedef const f32x4 (&AccRef)[2][2][4][2];
__device__ __forceinline__ void st_pair_rows(bf16* rowp, int ld, int fr, u32x4 A, u32x4 B) {
    const bool lo = fr < 8;
    const u32x4 send = lo ? B : A; u32x4 recv;
    recv.x = (unsigned)__builtin_amdgcn_update_dpp(0, (int)send.x, 0x128, 0xF, 0xF, true); recv.y = (unsigned)__builtin_amdgcn_update_dpp(0, (int)send.y, 0x128, 0xF, 0xF, true);
    recv.z = (unsigned)__builtin_amdgcn_update_dpp(0, (int)send.z, 0x128, 0xF, 0xF, true); recv.w = (unsigned)__builtin_amdgcn_update_dpp(0, (int)send.w, 0x128, 0xF, 0xF, true);
    bf16* p1 = rowp + (lo ? 0 : 8 - 8 * ld);
    *(u32x4*)p1 = lo ? A : recv;
    *(u32x4*)(p1 + 8 * ld) = lo ? recv : B;
}
__device__ __forceinline__ u32x4 pack8(f32x4 v0, f32x4 v1) { u32x4 w; w.x = cvt_pk_bf16(v0[0], v0[1]); w.y = cvt_pk_bf16(v0[2], v0[3]); w.z = cvt_pk_bf16(v1[0], v1[1]); w.w = cvt_pk_bf16(v1[2], v1[3]); return w; }
struct EpiProjEven {
    static constexpr bool ADJ = true;
    bf16* O;
    __device__ __forceinline__ void prefetch(LAS unsigned char*, const GUnit&, int) const {}
    __device__ __forceinline__ void operator()(AccRef acc, const GUnit& u, int wr, int wc, int fr, int fq, LAS unsigned char* lds, int wid) const {
        const int row0 = u.row0 + wr * 64 + fr, col = u.col0 + wc * 64 + 16 * fq; const bool act = u.col0 >= 1536;
#pragma unroll
        for (int ai = 0; ai < 2; ++ai)
#pragma unroll
            for (int m = 0; m < 4; ++m) { bf16* rowp = O + (size_t)(row0 + ai * HALF + m * 16) * EVEN_IN + col; u32x4 pk2[2];
#pragma unroll
                for (int bj = 0; bj < 2; ++bj) { f32x4 v0 = acc[ai][bj][m][0], v1 = acc[ai][bj][m][1];
                    if (act) {
                        constexpr float C1 = -2.0f * LOG2E * 0.7978845608028654f, C2 = C1 * 0.044715f;
#pragma unroll
                        for (int hv = 0; hv < 2; ++hv)
#pragma unroll
                            for (int jp = 0; jp < 2; ++jp) { const f32x4 vv = hv ? v1 : v0; const f32x2 x = (f32x2){vv[2 * jp], vv[2 * jp + 1]};
                                f32x2 a = __builtin_elementwise_fma(x * x, (f32x2){C2, C2}, (f32x2){C1, C1}) * x; a.x = __builtin_amdgcn_exp2f(a.x); a.y = __builtin_amdgcn_exp2f(a.y);
                                f32x2 d = a + 1.0f; d.x = __builtin_amdgcn_rcpf(d.x); d.y = __builtin_amdgcn_rcpf(d.y); const f32x2 r = x * d;
                                if (hv) { v1[2 * jp] = r.x; v1[2 * jp + 1] = r.y; } else { v0[2 * jp] = r.x; v0[2 * jp + 1] = r.y; } } }
                    pk2[bj] = pack8(v0, v1); }
                st_pair_rows(rowp, EVEN_IN, fr, pk2[0], pk2[1]); }
    }
};
struct EpiProjOdd {
    static constexpr bool ADJ = true;
    bf16* O; float* fz;
    __device__ __forceinline__ void prefetch(LAS unsigned char*, const GUnit&, int) const {}
    __device__ __forceinline__ void operator()(AccRef acc, const GUnit& u, int wr, int wc, int fr, int fq, LAS unsigned char* lds, int wid) const {
        const int row0 = u.row0 + wr * 64 + fr, col = u.col0 + wc * 64 + 16 * fq; const bool zt = (u.col0 == 1792) && (wc == 2) && (fq == 2);
#pragma unroll
        for (int ai = 0; ai < 2; ++ai)
#pragma unroll
            for (int m = 0; m < 4; ++m) { const int row = row0 + ai * HALF + m * 16; bf16* rowp = O + (size_t)row * ODD_LD + col;
                st_pair_rows(rowp, ODD_LD, fr, pack8(acc[ai][0][m][0], acc[ai][0][m][1]), pack8(acc[ai][1][m][0], acc[ai][1][m][1]));
                if (zt) { *(f32x4*)(fz + (size_t)row * 8) = acc[ai][0][m][0]; *(f32x4*)(fz + (size_t)row * 8 + 4) = acc[ai][0][m][1]; } }
    }
};
struct EpiQKV {
    static constexpr bool ADJ = true;
    bf16* Q; bf16* KV; const float* cosT; const float* sinT;
    __device__ __forceinline__ void prefetch(LAS unsigned char*, const GUnit&, int) const {}
    __device__ __forceinline__ void operator()(AccRef acc, const GUnit& u, int wr, int wc, int fr, int fq, LAS unsigned char* lds, int wid) const {
        const int row0 = u.row0 + wr * 64 + fr;
        if (u.col0 < 768) {
            const int col = u.col0 + wc * 64 + 16 * fq;
            bool rp[2]; int i0[2];
#pragma unroll
            for (int bj = 0; bj < 2; ++bj) { const int d = (col + 8 * bj) % 96; rp[bj] = d >= 64; i0[bj] = rp[bj] ? ((d - 64) >> 1) : 0; }
#pragma unroll
            for (int ai = 0; ai < 2; ++ai)
#pragma unroll
                for (int mh = 0; mh < 2; ++mh) {
                    f32x4 cc[2][2], ss[2][2];
#pragma unroll
                    for (int mm = 0; mm < 2; ++mm) { const int pos = (row0 + ai * HALF + (2 * mh + mm) * 16) & (SEQ - 1);
#pragma unroll
                        for (int bj = 0; bj < 2; ++bj) { cc[mm][bj] = *(const f32x4*)(cosT + pos * 16 + i0[bj]); ss[mm][bj] = *(const f32x4*)(sinT + pos * 16 + i0[bj]); } }
#pragma unroll
                    for (int mm = 0; mm < 2; ++mm) { const int m = 2 * mh + mm; const int row = row0 + ai * HALF + m * 16; u32x4 pk2[2];
#pragma unroll
                        for (int bj = 0; bj < 2; ++bj) { f32x4 v0 = acc[ai][bj][m][0], v1 = acc[ai][bj][m][1];
                            f32x4 c = cc[mm][bj], sn = ss[mm][bj]; const f32x4 a0 = v0, a1 = v1;
#pragma unroll
                            for (int j = 0; j < 4; ++j) { c[j] = rp[bj] ? c[j] : 1.0f; sn[j] = rp[bj] ? sn[j] : 0.0f; }
                            v0[0] = a0[0] * c[0] - a0[1] * sn[0]; v0[1] = a0[1] * c[0] + a0[0] * sn[0]; v0[2] = a0[2] * c[1] - a0[3] * sn[1]; v0[3] = a0[3] * c[1] + a0[2] * sn[1];
                            v1[0] = a1[0] * c[2] - a1[1] * sn[2]; v1[1] = a1[1] * c[2] + a1[0] * sn[2]; v1[2] = a1[2] * c[3] - a1[3] * sn[3]; v1[3] = a1[3] * c[3] + a1[2] * sn[3];
                            pk2[bj] = pack8(v0, v1); }
                        st_pair_rows(Q + (size_t)row * 768 + col, 768, fr, pk2[0], pk2[1]); } }
        } else {
            const int col = u.col0 - 768 + wc * 64 + 16 * fq;
#pragma unroll
            for (int ai = 0; ai < 2; ++ai)
#pragma unroll
                for (int m = 0; m < 4; ++m) { bf16* rowp = KV + (size_t)(row0 + ai * HALF + m * 16) * 1024 + col;
                    st_pair_rows(rowp, 1024, fr, pack8(acc[ai][0][m][0], acc[ai][0][m][1]), pack8(acc[ai][1][m][0], acc[ai][1][m][1])); }
        }
    }
};
struct EpiOutProj {
    static constexpr bool ADJ = true;
    bf16* P;
    __device__ __forceinline__ void prefetch(LAS unsigned char*, const GUnit&, int) const {}
    __device__ __forceinline__ void operator()(AccRef acc, const GUnit& u, int wr, int wc, int fr, int fq, LAS unsigned char* lds, int wid) const {
        const int row0 = u.row0 + wr * 64 + fr, col = u.col0 + wc * 64 + 16 * fq;
#pragma unroll
        for (int ai = 0; ai < 2; ++ai)
#pragma unroll
            for (int m = 0; m < 4; ++m) { bf16* rowp = P + (size_t)(row0 + ai * HALF + m * 16) * DM + col;
                st_pair_rows(rowp, DM, fr, pack8(acc[ai][0][m][0], acc[ai][0][m][1]), pack8(acc[ai][1][m][0], acc[ai][1][m][1])); }
    }
};
#ifdef PROBE_KDOUBLE
constexpr float W8_SCALE = 64.0f, W8_INV = 1.0f / 64.0f, W8_INV1 = 0.5f / 64.0f;
#else
constexpr float W8_SCALE = 64.0f, W8_INV = 1.0f / 64.0f, W8_INV1 = W8_INV;
#endif
__device__ __forceinline__ unsigned pk_fp8x4(float a, float b, float c, float d) { unsigned w = 0u; w = (unsigned)__builtin_amdgcn_cvt_pk_fp8_f32(a, b, (int)w, false); w = (unsigned)__builtin_amdgcn_cvt_pk_fp8_f32(c, d, (int)w, true); return w; }
struct EpiSwiGLU {
    static constexpr bool ADJ = false;
    unsigned char* H; const float* b1p;
    __device__ __forceinline__ void prefetch(LAS unsigned char* lds, const GUnit& u, int wid) const {
        int l_ = threadIdx.x; asm volatile("" : "+v"(l_)); l_ &= 63;
        __builtin_amdgcn_global_load_lds((const unsigned*)(b1p + (size_t)u.e * 2048 + u.col0 + l_ * 4), (LAS unsigned*)(lds + EPI_LDS_OFF + wid * 2048), 16, 0, 0); }
    __device__ __forceinline__ void operator()(AccRef acc, const GUnit& u, int wr, int wc, int fr, int fq, LAS unsigned char* lds, int wid) const {
        const int cl = wc * 32 + 8 * fq; const LAS float* bp = (const LAS float*)(lds + EPI_LDS_OFF + wid * 2048) + cl;
        f32x4 bg0 = *(const LAS f32x4*)bp, bg1 = *(const LAS f32x4*)(bp + 4), bl0 = *(const LAS f32x4*)(bp + HALF), bl1 = *(const LAS f32x4*)(bp + HALF + 4);
        const int ocol = (u.col0 >> 1) + cl;
        bl0 = bl0 + 1.0f; bl1 = bl1 + 1.0f;
#pragma unroll
        for (int ai = 0; ai < 2; ++ai)
#pragma unroll
            for (int m = 0; m < 4; ++m) { const int rl = ai * HALF + wr * 64 + m * 16 + fr;
                f32x4 o[2];
#pragma unroll
                for (int n = 0; n < 2; ++n) { const f32x4 ag = acc[ai][0][m][n], al = acc[ai][1][m][n], bg = n ? bg1 : bg0, bl = n ? bl1 : bl0;
#pragma unroll
                    for (int jp = 0; jp < 2; ++jp) {
                        f32x2 g2 = __builtin_elementwise_fma((f32x2){ag[2 * jp], ag[2 * jp + 1]}, (f32x2){W8_INV1, W8_INV1}, (f32x2){bg[2 * jp], bg[2 * jp + 1]});
                        f32x2 l2 = __builtin_elementwise_fma((f32x2){al[2 * jp], al[2 * jp + 1]}, (f32x2){W8_INV1, W8_INV1}, (f32x2){bl[2 * jp], bl[2 * jp + 1]});
                        g2.x = fminf(g2.x, 7.0f); g2.y = fminf(g2.y, 7.0f);
                        l2.x = __builtin_amdgcn_fmed3f(l2.x, -6.0f, 8.0f); l2.y = __builtin_amdgcn_fmed3f(l2.y, -6.0f, 8.0f);
                        f32x2 e2 = g2 * (-1.702f * LOG2E); e2.x = __builtin_amdgcn_exp2f(e2.x); e2.y = __builtin_amdgcn_exp2f(e2.y);
                        f32x2 d2 = e2 + 1.0f; d2.x = __builtin_amdgcn_rcpf(d2.x); d2.y = __builtin_amdgcn_rcpf(d2.y);
                        const f32x2 r2 = (g2 * d2) * l2;
                        o[n][2 * jp] = r2.x; o[n][2 * jp + 1] = r2.y; } }
                if (rl < u.nvalid) { u32x2 w; w.x = pk_fp8x4(o[0][0], o[0][1], o[0][2], o[0][3]); w.y = pk_fp8x4(o[1][0], o[1][1], o[1][2], o[1][3]); *(u32x2*)(H + (size_t)(u.row0 + rl) * DFF + ocol) = w; } }
    }
};
struct EpiMoeOut {
    static constexpr bool ADJ = true;
    unsigned char* O2; const float* b2; const float* glist;
    __device__ __forceinline__ void prefetch(LAS unsigned char* lds, const GUnit& u, int wid) const {
        int l_ = threadIdx.x; asm volatile("" : "+v"(l_)); l_ &= 63;
        __builtin_amdgcn_global_load_lds((const unsigned*)(b2 + (size_t)u.e * DM + u.col0 + l_ * 4), (LAS unsigned*)(lds + EPI_LDS_OFF + wid * 2048), 16, 0, 0);
        __builtin_amdgcn_global_load_lds((const unsigned*)(glist + u.lrow0 + l_ * 4), (LAS unsigned*)(lds + EPI_LDS_OFF + wid * 2048 + 1024), 16, 0, 0); }
    __device__ __forceinline__ void operator()(AccRef acc, const GUnit& u, int wr, int wc, int fr, int fq, LAS unsigned char* lds, int wid) const {
        const int col = u.col0 + wc * 64 + 16 * fq;
        const LAS float* bp = (const LAS float*)(lds + EPI_LDS_OFF + wid * 2048) + wc * 64 + 16 * fq; const LAS float* gp = (const LAS float*)(lds + EPI_LDS_OFF + wid * 2048 + 1024);
        float gv[2][4]; f32x4 bv[2][2];
#pragma unroll
        for (int ai = 0; ai < 2; ++ai)
#pragma unroll
            for (int m = 0; m < 4; ++m) gv[ai][m] = gp[ai * HALF + wr * 64 + m * 16 + fr];
#pragma unroll
        for (int bj = 0; bj < 2; ++bj) { bv[bj][0] = *(const LAS f32x4*)(bp + bj * 8); bv[bj][1] = *(const LAS f32x4*)(bp + bj * 8 + 4); }
        unsigned char* base = O2 + (size_t)(u.row0 + wr * 64 + fr) * DM + col;
#pragma unroll
        for (int ai = 0; ai < 2; ++ai)
#pragma unroll
            for (int m = 0; m < 4; ++m) { const int rl = ai * HALF + wr * 64 + m * 16 + fr; const bool ok = rl < u.nvalid; const float g = gv[ai][m];
                u32x2 w[2];
#pragma unroll
                for (int bj = 0; bj < 2; ++bj) { const f32x4 v0 = (acc[ai][bj][m][0] * W8_INV + bv[bj][0]) * g, v1 = (acc[ai][bj][m][1] * W8_INV + bv[bj][1]) * g; w[bj].x = pk_fp8x4(v0[0], v0[1], v0[2], v0[3]); w[bj].y = pk_fp8x4(v1[0], v1[1], v1[2], v1[3]); }
                if (ok) { unsigned char* rowp = base + (size_t)(ai * HALF + m * 16) * DM; *(u32x4*)rowp = (u32x4){w[0].x, w[0].y, w[1].x, w[1].y}; } }
    }
};
}

__device__ const float ROPE_INVF[16] = {1.0f, 0.5623413251903491f, 0.31622776601683794f, 0.1778279410038923f, 0.1f, 0.05623413251903491f, 0.03162277660168379f, 0.01778279410038923f,
                                        0.01f, 0.005623413251903491f, 0.0031622776601683794f, 0.0017782794100389228f, 0.001f, 0.0005623413251903491f, 0.00031622776601683794f, 0.00017782794100389227f};
template <int MODE, bool OUT8 = false>
__device__ __forceinline__ void tr_item(const float* W, int N, int Nvalid, int k0, int c0, bf16* dst, int ldd, LAS float* scr, int lane, const float* aux) {
    (void)scr;
    const int c = c0 + lane; const bool cok = c < Nvalid; const int cr = cok ? c : Nvalid - 1;
    float cs = cok ? 1.0f : 0.0f; if (MODE == 1) cs = (c >= 416 && c < 928) ? FOX_QS : cs; if (OUT8) cs *= pg8::W8_SCALE;
    const float* wp = W + (size_t)k0 * N + cr;
    int dr = c;
    if (MODE == 2) { const int h = c / 96, d = c - h * 96; if (d >= 64) dr = h * 96 + 64 + 2 * ((d - 64) & 15) + ((d - 64) >> 4); }
    if (MODE == 4) { const int j = c >> 1, half = c & 1; dr = (j >> 7) * 256 + half * 128 + (j & 127); }
    float t[64];
#pragma unroll
    for (int i = 0; i < 64; ++i) t[i] = wp[(size_t)i * N];
#pragma unroll
    for (int i = 0; i < 64; ++i) { t[i] *= cs; if (MODE == 2) t[i] *= aux[k0 + i] * MLA_QS; if (MODE == 3) t[i] *= aux[k0 + i]; }
    if (OUT8) { unsigned char* dp = (unsigned char*)dst + (size_t)dr * ldd + k0;
#pragma unroll
        for (int q = 0; q < 4; ++q) { u32x4 o; o.x = pg8::pk_fp8x4(t[16 * q], t[16 * q + 1], t[16 * q + 2], t[16 * q + 3]); o.y = pg8::pk_fp8x4(t[16 * q + 4], t[16 * q + 5], t[16 * q + 6], t[16 * q + 7]);
            o.z = pg8::pk_fp8x4(t[16 * q + 8], t[16 * q + 9], t[16 * q + 10], t[16 * q + 11]); o.w = pg8::pk_fp8x4(t[16 * q + 12], t[16 * q + 13], t[16 * q + 14], t[16 * q + 15]); *(u32x4*)(dp + 16 * q) = o; } }
    else { bf16* dp = dst + (size_t)dr * ldd + k0;
#pragma unroll
        for (int q = 0; q < 8; ++q) { u32x4 o; o.x = cvt_pk_bf16(t[8 * q], t[8 * q + 1]); o.y = cvt_pk_bf16(t[8 * q + 2], t[8 * q + 3]); o.z = cvt_pk_bf16(t[8 * q + 4], t[8 * q + 5]); o.w = cvt_pk_bf16(t[8 * q + 6], t[8 * q + 7]); *(u32x4*)(dp + 8 * q) = o; } }
}

template <int MODE>
__device__ __forceinline__ void tr_block256(const float* W, int N, int k0, int c0, unsigned char* dst, int lane, LAS unsigned char* xs) {
    const int c = c0 + 4 * lane;
    const f32x4* wp = (const f32x4*)(W + (size_t)k0 * N + c);
    unsigned pk[4][32];
#pragma unroll
    for (int kk = 0; kk < 8; ++kk) {
        f32x4 t[16];
#pragma unroll
        for (int i = 0; i < 16; ++i) t[i] = __builtin_nontemporal_load(wp + (size_t)(16 * kk + i) * (N / 4));
#pragma unroll
        for (int j = 0; j < 4; ++j)
#pragma unroll
            for (int q = 0; q < 4; ++q) pk[j][4 * kk + q] = pg8::pk_fp8x4(t[4 * q][j] * pg8::W8_SCALE, t[4 * q + 1][j] * pg8::W8_SCALE, t[4 * q + 2][j] * pg8::W8_SCALE, t[4 * q + 3][j] * pg8::W8_SCALE);
    }
#pragma unroll
    for (int j = 0; j < 4; ++j) {
#pragma unroll
        for (int q = 0; q < 8; ++q) *(LAS u32x4*)(xs + lane * 144 + 16 * q) = (u32x4){pk[j][4 * q], pk[j][4 * q + 1], pk[j][4 * q + 2], pk[j][4 * q + 3]};
#pragma unroll
        for (int r = 0; r < 8; ++r) { const int sl = 8 * r + (lane >> 3);
            const u32x4 v = *(const LAS u32x4*)(xs + sl * 144 + 16 * (lane & 7));
            const int cc = c0 + 4 * sl + j; int dr = cc;
            if (MODE == 4) { const int jj = cc >> 1, half = cc & 1; dr = (jj >> 7) * 256 + half * 128 + (jj & 127); }
            *(u32x4*)(dst + (size_t)dr * 1024 + k0 + 16 * (lane & 7)) = v; }
    }
}

struct Args { const float* in[25]; float* out; unsigned char* ws; int ph_lo, ph_hi; };

__device__ __forceinline__ void prologue_phase(const Args& a, LAS unsigned char* lds, int G, int c) {
    int tid_ = threadIdx.x; asm volatile("" : "+v"(tid_));
    const int tid = tid_, lane = tid & 63, wid = __builtin_amdgcn_readfirstlane(tid >> 6);
    LAS float* scr = (LAS float*)(lds + wid * 16640);
    unsigned char* ws = a.ws;
    const int gw = c * 8 + wid, NGW = G * 8;
    constexpr int I_W1 = 128 * 8 * 8, I_W2 = 128 * 8 * 4,         I_EVIN = 2 * 16 * 40, I_EVOUT = 2 * 16 * 16, I_ODIN = 2 * 16 * 32, I_ODOUT = 2 * 16 * 16, I_UQ = 2 * 4 * 12, I_UKV = 2 * 2 * 16;
    constexpr int TOTAL = I_W1 + I_W2 + I_EVIN + I_EVOUT + I_ODIN + I_ODOUT + I_UQ + I_UKV;
    for (int it = gw; it < TOTAL; it += NGW) {
        int r = it;
        if (r < I_W1) { const int mat = r >> 6, kp = (r >> 3) & 7, cb = r & 7;
            tr_block256<4>(a.in[21] + (size_t)mat * 1024 * 2048, 2048, kp * 128, cb * 256, ws + WS_W1T + (size_t)mat * 2048 * 1024, lane, (LAS unsigned char*)scr); continue; } r -= I_W1;
        if (r < I_W2) { const int mat = r >> 5, kp = (r >> 2) & 7, cb = r & 3;
            tr_block256<0>(a.in[23] + (size_t)mat * 1024 * 1024, 1024, kp * 128, cb * 256, ws + WS_W2T + (size_t)mat * 1024 * 1024, lane, (LAS unsigned char*)scr); continue; } r -= I_W2;
        if (r < I_EVIN) { const int mat = r / 640, q = r % 640, kb = q / 40, cb = q % 40;
            tr_item<0>(a.in[1] + (size_t)mat * 1024 * EVEN_IN, EVEN_IN, EVEN_IN, kb * 64, cb * 64, (bf16*)(ws + WS_EVIN) + (size_t)mat * EVEN_IN * 1024, 1024, scr, lane, nullptr); continue; } r -= I_EVIN;
        if (r < I_EVOUT) { const int mat = r >> 8, kb = (r >> 4) & 15, cb = r & 15;
            tr_item<0>(a.in[7] + (size_t)mat * 1024 * 1024, 1024, 1024, kb * 64, cb * 64, (bf16*)(ws + WS_EVOUT) + (size_t)mat * 1024 * 1024, 1024, scr, lane, nullptr); continue; } r -= I_EVOUT;
        if (r < I_ODIN) { const int mat = r >> 9, kb = (r >> 5) & 15, cb = r & 31;
            tr_item<1>(a.in[8] + (size_t)mat * 1024 * ODD_IN, ODD_IN, ODD_IN, kb * 64, cb * 64, (bf16*)(ws + WS_ODIN) + (size_t)mat * ODD_INP * 1024, 1024, scr, lane, nullptr); continue; } r -= I_ODIN;
        if (r < I_ODOUT) { const int mat = r >> 8, kb = (r >> 4) & 15, cb = r & 15;
            tr_item<0>(a.in[14] + (size_t)mat * 1024 * 1024, 1024, 1024, kb * 64, cb * 64, (bf16*)(ws + WS_ODOUT) + (size_t)mat * 1024 * 1024, 1024, scr, lane, nullptr); continue; } r -= I_ODOUT;
        if (r < I_UQ) { const int mat = r / 48, q = r % 48, kb = q / 12, cb = q % 12;
            tr_item<2>(a.in[11] + (size_t)mat * 256 * 768, 768, 768, kb * 64, cb * 64, (bf16*)(ws + WS_UQT) + (size_t)mat * 768 * 256, 256, scr, lane, a.in[9] + mat * 256); continue; } r -= I_UQ;
        { const int mat = r >> 5, kb = (r >> 4) & 1, cb = r & 15;
            tr_item<3>(a.in[12] + (size_t)mat * 128 * 1024, 1024, 1024, kb * 64, cb * 64, (bf16*)(ws + WS_UKVT) + (size_t)mat * 1024 * 256, 256, scr, lane, a.in[10] + mat * 128); }
    }
    const size_t gt = (size_t)c * 512 + tid, NGT = (size_t)G * 512;
    { const f32x4* x4 = (const f32x4*)a.in[0]; u32x2* xb = (u32x2*)(ws + WS_XB);
      static_assert(((size_t)NTOK * DM / 4) % (4 * 256 * 512) == 0, "x conversion: four float4 per thread per trip on the 256 x 512 grid");
      for (size_t i = gt; i + 3 * NGT < (size_t)NTOK * DM / 4; i += 4 * NGT) { f32x4 v[4];
#pragma unroll
          for (int q = 0; q < 4; ++q) v[q] = x4[i + q * NGT];
#pragma unroll
          for (int q = 0; q < 4; ++q) { u32x2 o; o.x = cvt_pk_bf16(v[q][0], v[q][1]); o.y = cvt_pk_bf16(v[q][2], v[q][3]); xb[i + q * NGT] = o; } } }
    { float* cosT = (float*)(ws + WS_ROPE); float* sinT = cosT + SEQ * 16;
      for (size_t i = gt; i < (size_t)SEQ * 16; i += NGT) { const int pos = (int)(i >> 4), k = (int)(i & 15);
          double r = (double)pos * (double)ROPE_INVF[k] * 0.15915494309189535; r -= floor(r); const float fr = (float)r;
          cosT[i] = __builtin_amdgcn_cosf(fr); sinT[i] = __builtin_amdgcn_sinf(fr); } }
    { bf16* wrt = (bf16*)(ws + WS_WRT); const float* wr = a.in[19];
      for (size_t i = gt; i < (size_t)DEPTH * NEXP * DM; i += NGT) { const int l = (int)(i >> 15), e = (int)(i >> 10) & 31, k = (int)(i & 1023); const float w = wr[((size_t)l * DM + k) * NEXP + e];
          const unsigned hi = f2bf(w), lo = f2bf(w - bf2f(hi)); const size_t d = ((size_t)l * 2 * NEXP + e) * DM + (size_t)(((k >> 3) ^ (e & 15)) * 8 + (k & 7));
          wrt[d] = (bf16)hi; wrt[d + (size_t)NEXP * DM] = (bf16)lo; } }
    { float* b1p = (float*)(ws + WS_B1P); const float* b1 = a.in[22];
      for (size_t i = gt; i < (size_t)DEPTH * NEXP * 2048; i += NGT) { const int np = (int)(i & 2047), pn = np >> 8, half = (np >> 7) & 1, cc = np & 127; b1p[i] = b1[(i & ~(size_t)2047) + 2 * (128 * pn + cc) + half]; } }
    { bf16* sw = (bf16*)(ws + WS_SGUW); const float* s = a.in[5];
      for (size_t i = gt; i < (size_t)2 * 8 * 128 * 128; i += NGT) { const int ii = (int)(i >> 7) & 127, jj = (int)(i & 127); sw[i] = ((jj >> 6) <= (ii >> 6)) ? (bf16)f2bf(s[i]) : (bf16)0; } }
    { bf16* uk = (bf16*)(ws + WS_UKVT);
      for (size_t i = gt; i < (size_t)2 * 1024 * 128; i += NGT) { const size_t row = i >> 7; uk[row * 256 + 128 + (i & 127)] = 0; } }
}

__device__ __forceinline__ void sgu_phase(LAS unsigned char* lds, const bf16* proj, bf16* y, const bf16* sguw, const float* ln_g, const float* ln_b, const float* sgu_b, const float* conv_w, int G, int c) {
    int tid_ = threadIdx.x; asm volatile("" : "+v"(tid_));
    const int tid = tid_, lane = tid & 63, wid = __builtin_amdgcn_readfirstlane(tid >> 6);
    constexpr int VST = 144;
    for (int unit = c; unit < 2048; unit += G) {
        const int blk = unit >> 3, g = unit & 7;
        const int j = tid >> 2, part = tid & 3;
        const size_t tok = (size_t)blk * 128 + j;
        bf16x8 wfr[4];
        { const bf16* wp0 = sguw + ((size_t)g * 128 + 16 * wid + (lane & 15)) * 128 + 8 * (lane >> 4);
#pragma unroll
          for (int ks = 0; ks < 4; ++ks) wfr[ks] = *(const bf16x8*)(wp0 + 32 * ks); }
        {
            const bf16* vp = proj + tok * EVEN_IN + 2048 + g * 64 + part * 16;
            const u32x4 r0 = *(const u32x4*)vp, r1 = *(const u32x4*)(vp + 8);
            float v[16];
            v[0] = bf2f(r0.x & 0xffffu); v[1] = bf2f(r0.x >> 16); v[2] = bf2f(r0.y & 0xffffu); v[3] = bf2f(r0.y >> 16); v[4] = bf2f(r0.z & 0xffffu); v[5] = bf2f(r0.z >> 16); v[6] = bf2f(r0.w & 0xffffu); v[7] = bf2f(r0.w >> 16);
            v[8] = bf2f(r1.x & 0xffffu); v[9] = bf2f(r1.x >> 16); v[10] = bf2f(r1.y & 0xffffu); v[11] = bf2f(r1.y >> 16); v[12] = bf2f(r1.z & 0xffffu); v[13] = bf2f(r1.z >> 16); v[14] = bf2f(r1.w & 0xffffu); v[15] = bf2f(r1.w >> 16);
            float s = 0.f;
#pragma unroll
            for (int i = 0; i < 16; ++i) s += v[i];
            s += __shfl_xor(s, 1); s += __shfl_xor(s, 2);
            const float mean = s * (1.0f / 64.0f); float q = 0.f;
#pragma unroll
            for (int i = 0; i < 16; ++i) { v[i] -= mean; q += v[i] * v[i]; }
            q += __shfl_xor(q, 1); q += __shfl_xor(q, 2);
            const float rstd = 1.0f / sqrtf(q * (1.0f / 64.0f) + LN_EPS);
            const float* gp = ln_g + g * 64 + part * 16; const float* bp = ln_b + g * 64 + part * 16;
            unsigned o[8];
#pragma unroll
            for (int i = 0; i < 16; i += 4) { const f32x4 g4 = *(const f32x4*)(gp + i), b4 = *(const f32x4*)(bp + i);
                o[i / 2] = cvt_pk_bf16(v[i] * rstd * g4[0] + b4[0], v[i + 1] * rstd * g4[1] + b4[1]); o[i / 2 + 1] = cvt_pk_bf16(v[i + 2] * rstd * g4[2] + b4[2], v[i + 3] * rstd * g4[3] + b4[3]); }
            LAS u32x4* dp = (LAS u32x4*)(lds + j * VST + part * 32);
            dp[0] = (u32x4){o[0], o[1], o[2], o[3]}; dp[1] = (u32x4){o[4], o[5], o[6], o[7]};
        }
        {
            const int pos = (int)(tok & (SEQ - 1)); const int ch0 = g * 64 + part * 16;
            const bf16* p0 = proj + tok * EVEN_IN + ch0;
            const float m1 = pos >= 1 ? 1.0f : 0.0f, m2 = pos >= 2 ? 1.0f : 0.0f;
            const int o1 = pos >= 1 ? EVEN_IN : 0, o2 = pos >= 2 ? 2 * EVEN_IN : 0;
            u32x4 c0[2], v0[2], b0[2], c1[2], v1[2], c2[2], v2[2]; f32x4 wt[3][2][2];
#pragma unroll
            for (int hf = 0; hf < 2; ++hf) { const bf16* p = p0 + hf * 8;
                c0[hf] = *(const u32x4*)p; v0[hf] = *(const u32x4*)(p + 1024); b0[hf] = *(const u32x4*)(p + 512);
                c1[hf] = *(const u32x4*)(p - o1); v1[hf] = *(const u32x4*)(p - o1 + 1024); c2[hf] = *(const u32x4*)(p - o2); v2[hf] = *(const u32x4*)(p - o2 + 1024);
#pragma unroll
                for (int tp = 0; tp < 3; ++tp) { wt[tp][hf][0] = *(const f32x4*)(conv_w + tp * 512 + ch0 + hf * 8); wt[tp][hf][1] = *(const f32x4*)(conv_w + tp * 512 + ch0 + hf * 8 + 4); } }
            u32x4 oh[2];
#pragma unroll
            for (int hf = 0; hf < 2; ++hf) {
                unsigned o[4];
#pragma unroll
                for (int k = 0; k < 4; ++k) {
                    const float w0a = wt[0][hf][k >> 1][(k & 1) * 2] * m2, w0b = wt[0][hf][k >> 1][(k & 1) * 2 + 1] * m2, w1a = wt[1][hf][k >> 1][(k & 1) * 2] * m1, w1b = wt[1][hf][k >> 1][(k & 1) * 2 + 1] * m1;
                    const float w2a = wt[2][hf][k >> 1][(k & 1) * 2], w2b = wt[2][hf][k >> 1][(k & 1) * 2 + 1];
                    const float h0a = bf2f(c0[hf][k] & 0xffffu) * bf2f(v0[hf][k] & 0xffffu), h0b = bf2f(c0[hf][k] >> 16) * bf2f(v0[hf][k] >> 16);
                    const float h1a = bf2f(c1[hf][k] & 0xffffu) * bf2f(v1[hf][k] & 0xffffu), h1b = bf2f(c1[hf][k] >> 16) * bf2f(v1[hf][k] >> 16);
                    const float h2a = bf2f(c2[hf][k] & 0xffffu) * bf2f(v2[hf][k] & 0xffffu), h2b = bf2f(c2[hf][k] >> 16) * bf2f(v2[hf][k] >> 16);
                    const float ya = bf2f(b0[hf][k] & 0xffffu) * (w0a * h2a + w1a * h1a + w2a * h0a), yb = bf2f(b0[hf][k] >> 16) * (w0b * h2b + w1b * h1b + w2b * h0b);
                    o[k] = cvt_pk_bf16(ya, yb); }
                oh[hf] = (u32x4){o[0], o[1], o[2], o[3]};
            }
            {
                const f32x4 pa = __builtin_bit_cast(f32x4, oh[0]), pb = __builtin_bit_cast(f32x4, oh[1]); const bool odd_ = (tid & 1) != 0;
                bf16* yq = y + tok * DM + g * 64 + 8 * (tid & 3);
                *(u32x4*)yq = __builtin_bit_cast(u32x4, quad_piece<0x50>(pa, pb, odd_)); *(u32x4*)(yq + 32) = __builtin_bit_cast(u32x4, quad_piece<0xFA>(pa, pb, odd_)); }
        }
        __syncthreads();
        {
            const int li = lane & 15, kq = lane >> 4;
            f32x4 acc[4];
#pragma unroll
            for (int cb = 0; cb < 4; ++cb) acc[cb] = (f32x4){0.f, 0.f, 0.f, 0.f};
#pragma unroll
            for (int ks = 0; ks < 4; ++ks) {
                const bf16x8 bfrag = wfr[ks];
#pragma unroll
                for (int cb = 0; cb < 4; ++cb) {
                    const LAS unsigned char* ap = lds + (32 * ks + 8 * kq + (li >> 2)) * VST + (16 * cb + 4 * (li & 3)) * 2;
                    const s16x4 lo = __builtin_bit_cast(s16x4, __builtin_amdgcn_ds_read_tr16_b64_v4i16((LAS s16x4*)ap));
                    const s16x4 hi = __builtin_bit_cast(s16x4, __builtin_amdgcn_ds_read_tr16_b64_v4i16((LAS s16x4*)(ap + 4 * VST)));
                    const bf16x8 afrag = (bf16x8){lo[0], lo[1], lo[2], lo[3], hi[0], hi[1], hi[2], hi[3]};
                    acc[cb] = __builtin_amdgcn_mfma_f32_16x16x32_bf16(afrag, bfrag, acc[cb], 0, 0, 0); } }
            const int irow = 16 * wid + li; const size_t trow = (size_t)blk * 128 + irow; const float bias = sgu_b[g * 128 + irow];
#pragma unroll
            for (int cb = 0; cb < 4; ++cb) { const int cg = g * 64 + 16 * cb + 4 * kq;
                const u32x2 ur = *(const u32x2*)(proj + trow * EVEN_IN + 1536 + cg);
                u32x2 o; o.x = cvt_pk_bf16(bf2f(ur.x & 0xffffu) * (acc[cb][0] + bias), bf2f(ur.x >> 16) * (acc[cb][1] + bias)); o.y = cvt_pk_bf16(bf2f(ur.y & 0xffffu) * (acc[cb][2] + bias), bf2f(ur.y >> 16) * (acc[cb][3] + bias));
                *(u32x2*)(y + trow * DM + 512 + cg) = o; }
        }
        __syncthreads();
    }
}

__device__ __forceinline__ float log_sigmoid(float z) { return fminf(z, 0.0f) - log1pf(expf(-fabsf(z))); }
__device__ __forceinline__ void odd_mid_phase(const bf16* proj, const float* fz, const float* fbias, bf16* cqn, bf16* ckvn, bf16* krope, float* fb, const float* cosT, const float* sinT, unsigned* kmax, int G, int c) {
    int tid_ = threadIdx.x; asm volatile("" : "+v"(tid_));
    const int tid = tid_, lane = tid & 63, wid = __builtin_amdgcn_readfirstlane(tid >> 6);
    const int gw = c * 8 + wid, NGW = G * 8;
    for (int blk = gw; blk < NTOK / 16; blk += NGW) {
        float km = 0.f;
        for (int r = 0; r < 16; ++r) {
            const int row = blk * 16 + r;
            const bf16* p = proj + (size_t)row * ODD_LD;
            const u32x2 a = *(const u32x2*)(p + 4 * lane); const unsigned b = *(const unsigned*)(p + 256 + 2 * lane);
            const u32x4 kk = *(const u32x4*)(p + 928 + 8 * lane);
            const float q0 = bf2f(a.x & 0xffffu), q1 = bf2f(a.x >> 16), q2 = bf2f(a.y & 0xffffu), q3 = bf2f(a.y >> 16), k0 = bf2f(b & 0xffffu), k1 = bf2f(b >> 16);
            const float rq = 1.0f / sqrtf(wave_sum(q0 * q0 + q1 * q1 + q2 * q2 + q3 * q3) * (1.0f / 256.0f) + LN_EPS);
            const float rk = 1.0f / sqrtf(wave_sum(k0 * k0 + k1 * k1) * (1.0f / 128.0f) + LN_EPS);
            u32x2 o; o.x = cvt_pk_bf16(q0 * rq, q1 * rq); o.y = cvt_pk_bf16(q2 * rq, q3 * rq);
            *(u32x2*)(cqn + (size_t)row * 256 + 4 * lane) = o;
            *(unsigned*)(ckvn + (size_t)row * 256 + 2 * lane) = cvt_pk_bf16(k0 * rk, k1 * rk);
            *(unsigned*)(ckvn + (size_t)row * 256 + 128 + 2 * lane) = 0u;
            if (lane < 16) { const float x1 = bf2f(p[384 + lane]), x2 = bf2f(p[400 + lane]); const int pos = row & (SEQ - 1); const float cs = cosT[pos * 16 + lane], sn = sinT[pos * 16 + lane];
                *(unsigned*)(krope + (size_t)row * 32 + 2 * lane) = cvt_pk_bf16(x1 * cs - x2 * sn, x2 * cs + x1 * sn); }
            float ks = 0.f;
#pragma unroll
            for (int i = 0; i < 4; ++i) { const float lo = bf2f(kk[i] & 0xffffu), hi = bf2f(kk[i] >> 16); ks += lo * lo + hi * hi; }
            ks += __shfl_xor(ks, 1); ks += __shfl_xor(ks, 2); ks += __shfl_xor(ks, 4);
            km = fmaxf(km, ks);
        }
        if ((lane & 7) == 0) atomicMax(kmax + ((blk * 16) >> 12) * 8 + (lane >> 3), __float_as_uint(km));
    }
    if (gw < 64) {
        const int b = gw >> 3, h = gw & 7; const float bias = fbias[h];
        const float* zp = fz + ((size_t)b * SEQ + (size_t)lane * 64) * 8 + h;
        float s = 0.f;
        for (int i = 0; i < 64; ++i) s += log_sigmoid(zp[(size_t)i * 8] + bias);
        float incl = s;
#pragma unroll
        for (int o = 1; o < 64; o <<= 1) { const float t = __shfl_up(incl, o); if (lane >= o) incl += t; }
        float run = incl - s;
        float* op = fb + (size_t)gw * SEQ + lane * 64;
        for (int i = 0; i < 64; ++i) { run += log_sigmoid(zp[(size_t)i * 8] + bias); op[i] = -run * LOG2E; }
    }
}

__device__ __forceinline__ int crow(int r, int hi) { return (r & 3) + 8 * (r >> 2) + 4 * hi; }
template <int MODE>
__device__ __forceinline__ void attn_unit(LAS unsigned char* lds, int b, int h, int qb, const bf16* qsrc, const bf16* kvsrc, const bf16* krope, const bf16* proj, const float* fb, bf16* y, const unsigned* kmax) {
    constexpr int DQ = MODE == 0 ? 96 : 64, ND = DQ / 16, KST = DQ * 2 + 16, VST = 192;
    constexpr int K_OFF = 0, V_OFF = 64 * KST, B_OFF = V_OFF + 64 * VST, BUFB = B_OFF + 256;
    constexpr float THR = 8.0f;
    int tid_ = threadIdx.x; asm volatile("" : "+v"(tid_));
    const int tid = tid_, lane = tid & 63, r32 = lane & 31, hi = lane >> 5, wid = __builtin_amdgcn_readfirstlane(tid >> 6);
    const size_t rowbase = (size_t)b * SEQ; const int q0 = qb * 256;
    const int qrow = q0 + wid * 32 + r32;
    bf16x8 qr[ND];
    { const bf16* qp = (MODE == 0) ? qsrc + (rowbase + qrow) * 768 + h * 96 + hi * 8 : proj + (rowbase + qrow) * ODD_LD + 416 + h * 64 + hi * 8;
#pragma unroll
      for (int d0 = 0; d0 < ND; ++d0) qr[d0] = *(const bf16x8*)(qp + d0 * 16); }
    const int NT = (q0 + 256) / 64;
    const int wlast = (q0 + wid * 32) / 64;
    int wfirst = 0, T0 = 0;
    if (MODE == 1) {
        float qs = 0.f, dk = 0.f;
        { const bf16* kp0 = proj + (rowbase + qrow) * ODD_LD + 928 + h * 64 + hi * 8;
          bf16x8 kr[ND];
#pragma unroll
          for (int d0 = 0; d0 < ND; ++d0) kr[d0] = *(const bf16x8*)(kp0 + d0 * 16);
#pragma unroll
          for (int d0 = 0; d0 < ND; ++d0)
#pragma unroll
            for (int i = 0; i < 8; ++i) { const float f = bf2f((unsigned)(unsigned short)qr[d0][i]), kf = bf2f((unsigned)(unsigned short)kr[d0][i]); qs += f * f; dk += f * kf; } }
        qs += __shfl_xor(qs, 32); dk += __shfl_xor(dk, 32);
        const float km2 = __uint_as_float(kmax[b * 8 + h]);
        const float* fbh = fb + ((size_t)(b * 8 + h)) * SEQ;
        float gmin = fbh[qrow] + dk - 43.4f - 1.01f * sqrtf(qs) * sqrtf(km2);
#pragma unroll
        for (int o = 16; o >= 1; o >>= 1) gmin = fminf(gmin, __shfl_xor(gmin, o));
        const float fj = fbh[64 * lane + 63];
        const unsigned long long sk = __ballot(lane < wlast && fj <= gmin);
        wfirst = __builtin_amdgcn_readfirstlane((int)__builtin_ctzll(~sk));
        LAS int* wf = (LAS int*)(lds + 5 * BUFB);
        if (lane == 0) wf[wid] = wfirst;
        __syncthreads();
        int m = wf[0];
#pragma unroll
        for (int w = 1; w < 8; ++w) m = min(m, wf[w]);
        T0 = __builtin_amdgcn_readfirstlane(m);
    }
    const int lr = tid >> 3, lc = tid & 7;
    const bf16* kg = (MODE == 0) ? kvsrc + (rowbase + lr) * 1024 + h * 128 + lc * 8 : proj + (rowbase + lr) * ODD_LD + 928 + h * 64 + lc * 8;
    const bf16* vg = (MODE == 0) ? kvsrc + (rowbase + lr) * 1024 + h * 128 + 64 + lc * 8 : proj + (rowbase + lr) * ODD_LD + 1440 + h * 64 + lc * 8;
    const size_t kvstep = (size_t)64 * ((MODE == 0) ? 1024 : ODD_LD);
    const bf16* rg = krope + (rowbase + ((tid & 255) >> 2)) * 32 + (tid & 3) * 8;
    const float* bg = fb + ((size_t)(b * 8 + h)) * SEQ + (tid & 63);
    u32x4 kreg[3], vreg[3], rreg[3]; float breg[3]; rreg[0] = rreg[1] = rreg[2] = (u32x4){0u, 0u, 0u, 0u}; breg[0] = breg[1] = breg[2] = 0.f;
#define ATT_GLOAD(t, S_) do { const int tt_ = min((int)(t), NT - 1); kreg[S_] = *(const u32x4*)(kg + (size_t)tt_ * kvstep); vreg[S_] = *(const u32x4*)(vg + (size_t)tt_ * kvstep); \
        if (MODE == 0) rreg[S_] = *(const u32x4*)(rg + (size_t)tt_ * 64 * 32); else breg[S_] = bg[tt_ * 64]; } while (0)
#define ATT_LSTORE(bo, S_) do { LAS unsigned char* bp_ = lds + (bo); *(LAS u32x4*)(bp_ + K_OFF + lr * KST + lc * 16) = kreg[S_]; *(LAS u32x4*)(bp_ + V_OFF + lr * VST + lc * 16) = vreg[S_]; \
        if (MODE == 0) { if (tid < 256) *(LAS u32x4*)(bp_ + K_OFF + (tid >> 2) * KST + 128 + (tid & 3) * 16) = rreg[S_]; } else { if (tid < 64) *(LAS float*)(bp_ + B_OFF + tid * 4) = breg[S_]; } } while (0)
#define ATT_QK(S, bo) do { const LAS unsigned char* bq_ = lds + (bo); \
        bf16x8 kf_[2][ND];     \
        _Pragma("unroll") for (int hh = 0; hh < 2; ++hh) { const LAS unsigned char* kp_ = bq_ + K_OFF + (32 * hh + r32) * KST + hi * 16; \
            _Pragma("unroll") for (int d0 = 0; d0 < ND; ++d0) kf_[hh][d0] = *(const LAS bf16x8*)(kp_ + d0 * 32); } \
        _Pragma("unroll") for (int hh = 0; hh < 2; ++hh) { \
            if (MODE == 1) { _Pragma("unroll") for (int rr = 0; rr < 4; ++rr) { const f32x4 bv_ = *(const LAS f32x4*)(bq_ + B_OFF + (32 * hh + 8 * rr + 4 * hi) * 4); \
                S[hh][4 * rr] = bv_[0] - mref; S[hh][4 * rr + 1] = bv_[1] - mref; S[hh][4 * rr + 2] = bv_[2] - mref; S[hh][4 * rr + 3] = bv_[3] - mref; } } \
            else { _Pragma("unroll") for (int r = 0; r < 16; ++r) S[hh][r] = -mref; } } \
        __builtin_amdgcn_sched_barrier(0); \
        _Pragma("unroll") for (int d0 = 0; d0 < ND; ++d0) _Pragma("unroll") for (int hh = 0; hh < 2; ++hh) S[hh] = __builtin_amdgcn_mfma_f32_32x32x16_bf16(kf_[hh][d0], qr[d0], S[hh], 0, 0, 0); \
        __builtin_amdgcn_sched_barrier(0); } while (0)
#define ATT_VLOAD(VF, bo) do { const LAS unsigned char* bv0_ = lds + (bo); \
        _Pragma("unroll") for (int hh = 0; hh < 2; ++hh) _Pragma("unroll") for (int s_ = 0; s_ < 2; ++s_) _Pragma("unroll") for (int d0 = 0; d0 < 2; ++d0) { \
            const LAS unsigned char* vp_ = bv0_ + V_OFF + (32 * hh + 16 * s_ + 4 * hi + ((lane & 15) >> 2)) * VST + (32 * d0 + 16 * ((lane >> 4) & 1) + 4 * (lane & 3)) * 2; \
            const s16x4 lo_ = __builtin_bit_cast(s16x4, __builtin_amdgcn_ds_read_tr16_b64_v4i16((LAS s16x4*)vp_)); \
            const s16x4 hv_ = __builtin_bit_cast(s16x4, __builtin_amdgcn_ds_read_tr16_b64_v4i16((LAS s16x4*)(vp_ + 8 * VST))); \
            VF[hh][s_][d0] = (bf16x8){lo_[0], lo_[1], lo_[2], lo_[3], hv_[0], hv_[1], hv_[2], hv_[3]}; } } while (0)
    float mref = 0.f, lsum = 0.f; f32x16 o[2]; o[0] = f32x16{}; o[1] = f32x16{};
    bool fresh = true;
    int b0 = 0, b1 = BUFB, b2 = 2 * BUFB, b3 = 3 * BUFB, b4 = 4 * BUFB;
    ATT_GLOAD(T0, 0); ATT_GLOAD(T0 + 1, 1); ATT_GLOAD(T0 + 2, 2);
    ATT_LSTORE(b0, 0); if (T0 + 1 < NT) ATT_LSTORE(b1, 1); if (T0 + 2 < NT) ATT_LSTORE(b2, 2);
    ATT_GLOAD(T0 + 3, 0); ATT_GLOAD(T0 + 4, 1);
    __syncthreads();
    f32x16 sA[2], sB[2];
    if (T0 >= wfirst && T0 <= wlast) ATT_QK(sA, b0);
#define ATT_STEP(SC, SN, t, S_, BAR_) do { \
        if ((t) + 3 < NT) ATT_LSTORE(b3, S_);      \
        ATT_GLOAD((t) + 5, S_); \
        const bool doS_ = ((t) + 1 < NT) && ((t) + 1 >= wfirst) && ((t) + 1 <= wlast); \
        const bool doP_ = ((t) >= wfirst) && ((t) <= wlast); \
        if (doS_) ATT_QK(SN, b1); \
        if (doP_) { \
            bf16x8 vf_[2][2][2]; ATT_VLOAD(vf_, b0); __builtin_amdgcn_sched_barrier(0); \
            if (MODE == 1 && (t) == wlast) { \
                _Pragma("unroll") for (int hh = 0; hh < 2; ++hh) _Pragma("unroll") for (int r = 0; r < 16; ++r) { const int kv_ = 64 * (t) + 32 * hh + crow(r, hi); if (kv_ > qrow) SC[hh][r] = -INFINITY; } } \
            float mx_ = fmaxf(fmaxf(SC[0][0], SC[0][1]), SC[1][0]); \
            _Pragma("unroll") for (int r = 2; r < 16; r += 2) mx_ = fmaxf(fmaxf(mx_, SC[0][r]), SC[0][r + 1]); \
            _Pragma("unroll") for (int r = 1; r < 15; r += 2) mx_ = fmaxf(fmaxf(mx_, SC[1][r]), SC[1][r + 1]); \
            mx_ = fmaxf(mx_, SC[1][15]); \
            { auto rr_ = __builtin_amdgcn_permlane32_swap(__float_as_uint(mx_), __float_as_uint(mx_), false, false); mx_ = fmaxf(__uint_as_float(rr_[0]), __uint_as_float(rr_[1])); } \
            if (fresh || __any(mx_ > THR)) { \
                const float dl_ = fresh ? mx_ : fmaxf(mx_, 0.f); mref += dl_; \
                _Pragma("unroll") for (int hh = 0; hh < 2; ++hh) _Pragma("unroll") for (int r = 0; r < 16; ++r) SC[hh][r] -= dl_; \
                if (doS_) { _Pragma("unroll") for (int hh = 0; hh < 2; ++hh) _Pragma("unroll") for (int r = 0; r < 16; ++r) SN[hh][r] -= dl_; } \
                if (!fresh) { const float al_ = __builtin_amdgcn_exp2f(-dl_); lsum *= al_; \
                    _Pragma("unroll") for (int d0 = 0; d0 < 2; ++d0) _Pragma("unroll") for (int r = 0; r < 16; ++r) o[d0][r] *= al_; } \
                fresh = false; } \
            float ps_ = 0.f; \
            _Pragma("unroll") for (int hh = 0; hh < 2; ++hh) _Pragma("unroll") for (int r = 0; r < 16; ++r) { SC[hh][r] = __builtin_amdgcn_exp2f(SC[hh][r]); ps_ += SC[hh][r]; } \
            lsum += ps_; \
            __builtin_amdgcn_sched_barrier(0); \
            _Pragma("unroll") for (int hh = 0; hh < 2; ++hh) _Pragma("unroll") for (int s_ = 0; s_ < 2; ++s_) { \
                u32x4 pw_; pw_.x = cvt_pk_bf16(SC[hh][8 * s_], SC[hh][8 * s_ + 1]); pw_.y = cvt_pk_bf16(SC[hh][8 * s_ + 2], SC[hh][8 * s_ + 3]); pw_.z = cvt_pk_bf16(SC[hh][8 * s_ + 4], SC[hh][8 * s_ + 5]); pw_.w = cvt_pk_bf16(SC[hh][8 * s_ + 6], SC[hh][8 * s_ + 7]); \
                const bf16x8 pf_ = __builtin_bit_cast(bf16x8, pw_); \
                _Pragma("unroll") for (int d0 = 0; d0 < 2; ++d0) o[d0] = __builtin_amdgcn_mfma_f32_32x32x16_bf16(vf_[hh][s_][d0], pf_, o[d0], 0, 0, 0); } } \
        if (BAR_) __syncthreads(); \
        { const int tb_ = b0; b0 = b1; b1 = b2; b2 = b3; b3 = b4; b4 = tb_; } } while (0)
    int t = T0;
    for (; t + 1 < NT; t += 2) { ATT_STEP(sA, sB, t, 0, 0); ATT_STEP(sB, sA, t + 1, 1, 1); }
    if (t < NT) ATT_STEP(sA, sB, t, 0, 1);
#undef ATT_STEP
#undef ATT_QK
#undef ATT_VLOAD
#undef ATT_GLOAD
#undef ATT_LSTORE
    lsum += __shfl_xor(lsum, 32);
    const float rl = 1.0f / lsum;
    LAS unsigned char* ys = lds + wid * 4608;
#pragma unroll
    for (int d0 = 0; d0 < 2; ++d0)
#pragma unroll
        for (int rr = 0; rr < 4; ++rr) { u32x2 w; w.x = cvt_pk_bf16(o[d0][4 * rr] * rl, o[d0][4 * rr + 1] * rl); w.y = cvt_pk_bf16(o[d0][4 * rr + 2] * rl, o[d0][4 * rr + 3] * rl);
            *(LAS u32x2*)(ys + r32 * 144 + (32 * d0 + 8 * rr + 4 * hi) * 2) = w; }
    bf16* yb_ = y + (rowbase + q0 + wid * 32) * DM + (MODE == 0 ? 0 : 512) + h * 64 + 8 * (lane & 7);
#pragma unroll
    for (int i = 0; i < 4; ++i) { const int row = 8 * i + (lane >> 3); const u32x4 v = *(const LAS u32x4*)(ys + row * 144 + 16 * (lane & 7)); *(u32x4*)(yb_ + (size_t)row * DM) = v; }
}
__device__ __forceinline__ void attn_phase(LAS unsigned char* lds, const bf16* q, const bf16* kv, const bf16* krope, const bf16* proj, const float* fb, bf16* y, const unsigned* kmax, unsigned* qhead) {
    LAS int* qslot = (LAS int*)(lds + 135168);
    unsigned nxt_idx = 0u;
    if (threadIdx.x == 0) qslot[0] = (int)__hip_atomic_fetch_add(qhead, 1u, __ATOMIC_RELAXED, __HIP_MEMORY_SCOPE_AGENT);
    __syncthreads();
    int idx = qslot[0];
    while (idx < 2048) {
        __syncthreads();
        if (threadIdx.x == 0) nxt_idx = __hip_atomic_fetch_add(qhead, 1u, __ATOMIC_RELAXED, __HIP_MEMORY_SCOPE_AGENT);
        const int kind = idx >> 10, id = idx & 1023, qb = 15 - (id >> 6), bh = id & 63;
        if (kind == 0) attn_unit<0>(lds, bh >> 3, bh & 7, qb, q, kv, krope, proj, fb, y, kmax);
        else attn_unit<1>(lds, bh >> 3, bh & 7, qb, q, kv, krope, proj, fb, y, kmax);
        if (threadIdx.x == 0) qslot[0] = (int)nxt_idx;
        __syncthreads();
        idx = qslot[0];
    }
}

__device__ __forceinline__ f32x4 ld_bf4(const bf16* p) { const u32x2 r = *(const u32x2*)p; f32x4 v; v[0] = bf2f(r.x & 0xffffu); v[1] = bf2f(r.x >> 16); v[2] = bf2f(r.y & 0xffffu); v[3] = bf2f(r.y >> 16); return v; }
__device__ __forceinline__ void st_bf4(bf16* p, f32x4 v) { u32x2 o; o.x = cvt_pk_bf16(v[0], v[1]); o.y = cvt_pk_bf16(v[2], v[3]); *(u32x2*)p = o; }
__device__ __forceinline__ float hsum4(f32x4 v) { return (v[0] + v[1]) + (v[2] + v[3]); }

__device__ __forceinline__ void ln1_phase(LAS unsigned char* lds, const bf16* pre, const bf16* xres, bf16* xb, bf16* xl, unsigned char* x8, const float* g, const float* b, const bf16* wrt, const float* brt, unsigned* cnt, unsigned* list, float* glist, unsigned* tokinfo, int G, int c) {
    int tid_ = threadIdx.x; asm volatile("" : "+v"(tid_));
    const int tid = tid_, lane = tid & 63, wid = __builtin_amdgcn_readfirstlane(tid >> 6);
    LAS float* scr = (LAS float*)(lds + 131072) + wid * 512;
    LAS unsigned* rec_e = (LAS unsigned*)(lds + 147456);
    LAS float* rec_g = (LAS float*)(lds + 149504);
    LAS unsigned* lcnt = (LAS unsigned*)(lds + 151552);
    LAS unsigned* gbase = (LAS unsigned*)(lds + 151680);
    { f32x4 wv[16];
#pragma unroll
      for (int i = 0; i < 16; ++i) wv[i] = ((const f32x4*)wrt)[tid + 512 * i];
#pragma unroll
      for (int i = 0; i < 16; ++i) ((LAS f32x4*)lds)[tid + 512 * i] = wv[i]; }
    f32x4 g4[4], b4[4];
#pragma unroll
    for (int q = 0; q < 4; ++q) { const int cq = 8 * lane + 512 * (q >> 1) + 4 * (q & 1); g4[q] = *(const f32x4*)(g + cq); b4[q] = *(const f32x4*)(b + cq); }
    const float br = brt[lane & 31];
    for (int chunk = c; chunk < NTOK / 128; chunk += G) {
        if (tid < 32) lcnt[tid] = 0u;
        __syncthreads();
        const int row0 = chunk * 128 + wid * 16;
        u32x4 raw[4][2], rax[4][2];
#pragma unroll
        for (int rr = 0; rr < 4; ++rr)
#pragma unroll
            for (int j = 0; j < 2; ++j) { raw[rr][j] = *(const u32x4*)(pre + (size_t)(row0 + rr) * DM + 8 * lane + 512 * j); rax[rr][j] = *(const u32x4*)(xres + (size_t)(row0 + rr) * DM + 8 * lane + 512 * j); }
        for (int it = 0; it < 4; ++it) {
            const int rbase = row0 + it * 4;
            f32x4 v[4][4];
#pragma unroll
            for (int rr = 0; rr < 4; ++rr)
#pragma unroll
                for (int j = 0; j < 2; ++j) { const u32x4 m_ = raw[rr][j], x_ = rax[rr][j];
                    v[rr][2 * j][0] = bf2f(m_.x & 0xffffu) + DN_ALPHA * bf2f(x_.x & 0xffffu); v[rr][2 * j][1] = bf2f(m_.x >> 16) + DN_ALPHA * bf2f(x_.x >> 16);
                    v[rr][2 * j][2] = bf2f(m_.y & 0xffffu) + DN_ALPHA * bf2f(x_.y & 0xffffu); v[rr][2 * j][3] = bf2f(m_.y >> 16) + DN_ALPHA * bf2f(x_.y >> 16);
                    v[rr][2 * j + 1][0] = bf2f(m_.z & 0xffffu) + DN_ALPHA * bf2f(x_.z & 0xffffu); v[rr][2 * j + 1][1] = bf2f(m_.z >> 16) + DN_ALPHA * bf2f(x_.z >> 16);
                    v[rr][2 * j + 1][2] = bf2f(m_.w & 0xffffu) + DN_ALPHA * bf2f(x_.w & 0xffffu); v[rr][2 * j + 1][3] = bf2f(m_.w >> 16) + DN_ALPHA * bf2f(x_.w >> 16); }
            if (it < 3) {
#pragma unroll
                for (int rr = 0; rr < 4; ++rr)
#pragma unroll
                    for (int j = 0; j < 2; ++j) { raw[rr][j] = *(const u32x4*)(pre + (size_t)(rbase + 4 + rr) * DM + 8 * lane + 512 * j); rax[rr][j] = *(const u32x4*)(xres + (size_t)(rbase + 4 + rr) * DM + 8 * lane + 512 * j); } }
#pragma unroll
            for (int rr = 0; rr < 4; ++rr) {
                float s = 0.f;
#pragma unroll
                for (int q = 0; q < 4; ++q) s += hsum4(v[rr][q]);
                const float mean = wave_sum(s) * (1.0f / DM); float qv = 0.f;
#pragma unroll
                for (int q = 0; q < 4; ++q) { v[rr][q] = v[rr][q] - mean; qv += hsum4(v[rr][q] * v[rr][q]); }
                const float rstd = 1.0f / sqrtf(wave_sum(qv) * (1.0f / DM) + LN_EPS);
#pragma unroll
                for (int j = 0; j < 2; ++j) { const f32x4 x0 = v[rr][2 * j] * rstd * g4[2 * j] + b4[2 * j], x1 = v[rr][2 * j + 1] * rstd * g4[2 * j + 1] + b4[2 * j + 1];
                    const size_t o = (size_t)(rbase + rr) * DM + 8 * lane + 512 * j;
                    u32x4 h; h.x = cvt_pk_bf16(x0[0], x0[1]); h.y = cvt_pk_bf16(x0[2], x0[3]); h.z = cvt_pk_bf16(x1[0], x1[1]); h.w = cvt_pk_bf16(x1[2], x1[3]); *(u32x4*)(xb + o) = h;
                    u32x4 l; l.x = cvt_pk_bf16(x0[0] - bf2f(h.x & 0xffffu), x0[1] - bf2f(h.x >> 16)); l.y = cvt_pk_bf16(x0[2] - bf2f(h.y & 0xffffu), x0[3] - bf2f(h.y >> 16));
                    l.z = cvt_pk_bf16(x1[0] - bf2f(h.z & 0xffffu), x1[1] - bf2f(h.z >> 16)); l.w = cvt_pk_bf16(x1[2] - bf2f(h.w & 0xffffu), x1[3] - bf2f(h.w >> 16)); *(u32x4*)(xl + o) = l;
                    u32x2 e8; e8.x = pg8::pk_fp8x4(x0[0], x0[1], x0[2], x0[3]); e8.y = pg8::pk_fp8x4(x1[0], x1[1], x1[2], x1[3]); *(u32x2*)(x8 + o) = e8; }
            }
        }
        asm volatile("s_waitcnt vmcnt(0)" ::: "memory");
        __builtin_amdgcn_fence(__ATOMIC_ACQUIRE, "workgroup");
        {
            const int li = lane & 15, kq = lane >> 4;
            const bf16* ah_p = xb + (size_t)(row0 + li) * DM + 8 * kq; const bf16* al_p = xl + (size_t)(row0 + li) * DM + 8 * kq;
            f32x4 acc[2]; acc[0] = (f32x4){0.f, 0.f, 0.f, 0.f}; acc[1] = acc[0];
            bf16x8 ah[2][4], al[2][4];
#pragma unroll
            for (int k4 = 0; k4 < 4; ++k4) { ah[0][k4] = *(const bf16x8*)(ah_p + 32 * k4); al[0][k4] = *(const bf16x8*)(al_p + 32 * k4); }
#define LN1_MMA(buf, bt_) do { _Pragma("unroll") for (int k4 = 0; k4 < 4; ++k4) { const int ks = 4 * (bt_) + k4; \
                _Pragma("unroll") for (int nb = 0; nb < 2; ++nb) { const int e = 16 * nb + li; const LAS unsigned char* wp = lds + e * 2048 + (((4 * ks + kq) ^ li) << 4); \
                    const bf16x8 wh = *(const LAS bf16x8*)wp, wl = *(const LAS bf16x8*)(wp + 65536); \
                    acc[nb] = __builtin_amdgcn_mfma_f32_16x16x32_bf16(ah[buf][k4], wh, acc[nb], 0, 0, 0); \
                    acc[nb] = __builtin_amdgcn_mfma_f32_16x16x32_bf16(al[buf][k4], wh, acc[nb], 0, 0, 0); \
                    acc[nb] = __builtin_amdgcn_mfma_f32_16x16x32_bf16(ah[buf][k4], wl, acc[nb], 0, 0, 0); } } } while (0)
#pragma unroll 1
            for (int bt = 0; bt < 8; bt += 2) {
#pragma unroll
                for (int k4 = 0; k4 < 4; ++k4) { ah[1][k4] = *(const bf16x8*)(ah_p + 32 * (4 * (bt + 1) + k4)); al[1][k4] = *(const bf16x8*)(al_p + 32 * (4 * (bt + 1) + k4)); }
                LN1_MMA(0, bt);
                if (bt < 6) {
#pragma unroll
                    for (int k4 = 0; k4 < 4; ++k4) { ah[0][k4] = *(const bf16x8*)(ah_p + 32 * (4 * (bt + 2) + k4)); al[0][k4] = *(const bf16x8*)(al_p + 32 * (4 * (bt + 2) + k4)); } }
                LN1_MMA(1, bt + 1);
            }
#undef LN1_MMA
#pragma unroll
            for (int nb = 0; nb < 2; ++nb)
#pragma unroll
                for (int r = 0; r < 4; ++r) scr[(4 * kq + r) * 32 + 16 * nb + li] = acc[nb][r];
        }
        asm volatile("s_waitcnt lgkmcnt(0)" ::: "memory");
        const int half = lane >> 5, e = lane & 31;
#pragma unroll 1
        for (int ps = 0; ps < 8; ++ps) {
            const int rr = 2 * ps + half;
            float val = scr[rr * 32 + e] + br;
            float tv[4]; int te[4];
#pragma unroll
            for (int k = 0; k < 4; ++k) {
                float m = val;
                m = fmaxf(m, __shfl_xor(m, 16)); m = fmaxf(m, __shfl_xor(m, 8)); m = fmaxf(m, __shfl_xor(m, 4)); m = fmaxf(m, __shfl_xor(m, 2)); m = fmaxf(m, __shfl_xor(m, 1));
                const unsigned long long bal = __ballot(val == m);
                const unsigned hm = half ? (unsigned)(bal >> 32) : (unsigned)bal;
                const int sel = __ffs((int)hm) - 1;
                tv[k] = m; te[k] = sel; if (e == sel) val = -INFINITY;
            }
            const float w1 = __expf(tv[1] - tv[0]), w2 = __expf(tv[2] - tv[0]), w3 = __expf(tv[3] - tv[0]);
            const float inv = 1.0f / (1.0f + w1 + w2 + w3);
            if (e < 4) {
                const int me = (e == 0) ? te[0] : (e == 1) ? te[1] : (e == 2) ? te[2] : te[3];
                const float mg = ((e == 0) ? 1.0f : (e == 1) ? w1 : (e == 2) ? w2 : w3) * inv;
                const unsigned lrank = __hip_atomic_fetch_add(lcnt + me, 1u, __ATOMIC_RELAXED, __HIP_MEMORY_SCOPE_WORKGROUP);
                const int ri = (wid * 16 + rr) * 4 + e;
                rec_e[ri] = (unsigned)me | (lrank << 8); rec_g[ri] = mg;
            }
        }
        __syncthreads();
        if (tid < 32) gbase[tid] = __hip_atomic_fetch_add(cnt + tid * CNT_STRIDE, lcnt[tid], __ATOMIC_RELAXED, __HIP_MEMORY_SCOPE_AGENT);
        __syncthreads();
        { const unsigned re = rec_e[tid]; const int e2 = (int)(re & 0xffu); const unsigned rank = gbase[e2] + (re >> 8); const unsigned tk = (unsigned)(chunk * 128 + (tid >> 2)) * 4u + (unsigned)(tid & 3);
          list[(size_t)e2 * CAP + rank] = tk; glist[(size_t)e2 * CAP + rank] = rec_g[tid]; tokinfo[tk] = ((unsigned)e2 << 24) | rank; }
        __syncthreads();
    }
}

__device__ __forceinline__ void unpack8(const u32x4 r, f32x4& a, f32x4& b) { a[0] = bf2f(r.x & 0xffffu); a[1] = bf2f(r.x >> 16); a[2] = bf2f(r.y & 0xffffu); a[3] = bf2f(r.y >> 16); b[0] = bf2f(r.z & 0xffffu); b[1] = bf2f(r.z >> 16); b[2] = bf2f(r.w & 0xffffu); b[3] = bf2f(r.w >> 16); }
__device__ __forceinline__ f32x4 unpack_fp8x4(unsigned w) { const f32x2 lo = __builtin_amdgcn_cvt_pk_f32_fp8((int)w, false), hi = __builtin_amdgcn_cvt_pk_f32_fp8((int)w, true); return (f32x4){lo.x, lo.y, hi.x, hi.y}; }
__device__ __forceinline__ void ln2_phase(const unsigned char* out2, const bf16* xb, bf16* xo, const float* g, const float* b, const unsigned* cnt, const unsigned* tokinfo, float* outf, int G, int c) {
    int tid_ = threadIdx.x; asm volatile("" : "+v"(tid_));
    const int tid = tid_, lane = tid & 63, wid = __builtin_amdgcn_readfirstlane(tid >> 6);
    unsigned offs;
    { const unsigned cn = (lane < NEXP) ? __hip_atomic_load(cnt + lane * CNT_STRIDE, __ATOMIC_RELAXED, __HIP_MEMORY_SCOPE_AGENT) : 0u; const unsigned mt = (cn + 255u) >> 8; unsigned incl = mt;
#pragma unroll
      for (int o = 1; o < 64; o <<= 1) { const unsigned t = __shfl_up(incl, o); if (lane >= o) incl += t; }
      offs = (incl - mt) * 256u; }
    f32x4 g4[4], b4[4];
#pragma unroll
    for (int q = 0; q < 4; ++q) { const int cq = 8 * lane + 512 * (q >> 1) + 4 * (q & 1); g4[q] = *(const f32x4*)(g + cq); b4[q] = *(const f32x4*)(b + cq); }
    for (int blk = c * 8 + wid; blk < NTOK / 16; blk += G * 8) {
        const int row0 = blk * 16;
        const unsigned info = tokinfo[(size_t)row0 * 4 + lane];
        const unsigned slot = (unsigned)__shfl((int)offs, (int)(info >> 24)) + (info & 0xffffffu);
        u32x4 cx[2], ce[4], nx[2], ne[4];
        { const bf16* xp_ = xb + (size_t)row0 * DM + 8 * lane; cx[0] = *(const u32x4*)xp_; cx[1] = *(const u32x4*)(xp_ + 512);
#pragma unroll
          for (int k = 0; k < 4; ++k) { const unsigned sl_ = (unsigned)__builtin_amdgcn_readlane((int)slot, k); const unsigned char* ep_ = out2 + (size_t)sl_ * DM + 8 * lane;
              const u32x2 ea_ = *(const u32x2*)ep_, eb_ = *(const u32x2*)(ep_ + 512); ce[k] = (u32x4){ea_.x, ea_.y, eb_.x, eb_.y}; } }
#pragma unroll 1
        for (int r = 0; r < 16; ++r) {
            const int rn = (r < 15) ? r + 1 : 15;
            {
                const bf16* xp_ = xb + (size_t)(row0 + rn) * DM + 8 * lane; nx[0] = *(const u32x4*)xp_; nx[1] = *(const u32x4*)(xp_ + 512);
#pragma unroll
                for (int k = 0; k < 4; ++k) { const unsigned sl_ = (unsigned)__shfl((int)slot, 4 * rn + k); const unsigned char* ep_ = out2 + (size_t)sl_ * DM + 8 * lane;
                    const u32x2 ea_ = *(const u32x2*)ep_, eb_ = *(const u32x2*)(ep_ + 512); ne[k] = (u32x4){ea_.x, ea_.y, eb_.x, eb_.y}; }
            }
            f32x4 v[4];
            unpack8(cx[0], v[0], v[1]); unpack8(cx[1], v[2], v[3]);
#pragma unroll
            for (int q = 0; q < 4; ++q) v[q] = v[q] * DN_ALPHA;
#pragma unroll
            for (int k = 0; k < 4; ++k) { v[0] = v[0] + unpack_fp8x4(ce[k].x); v[1] = v[1] + unpack_fp8x4(ce[k].y); v[2] = v[2] + unpack_fp8x4(ce[k].z); v[3] = v[3] + unpack_fp8x4(ce[k].w); }
            float s = 0.f;
#pragma unroll
            for (int q = 0; q < 4; ++q) s += hsum4(v[q]);
            const float mean = wave_sum(s) * (1.0f / DM); float qq = 0.f;
#pragma unroll
            for (int q = 0; q < 4; ++q) { v[q] = v[q] - mean; qq += hsum4(v[q] * v[q]); }
            const float rstd = 1.0f / sqrtf(wave_sum(qq) * (1.0f / DM) + LN_EPS);
#pragma unroll
            for (int q = 0; q < 4; ++q) v[q] = v[q] * rstd * g4[q] + b4[q];
            bf16* op = xo + (size_t)(row0 + r) * DM + 8 * lane;
            if (!outf) { *(u32x4*)op = pg8::pack8(v[0], v[1]); *(u32x4*)(op + 512) = pg8::pack8(v[2], v[3]); }
            else {
                float* fq_ = outf + (size_t)(row0 + r) * DM + 8 * (lane & ~3) + 4 * (lane & 3);
                const bool odd_ = (lane & 1) != 0;
                *(f32x4*)fq_ = quad_piece<0x50>(v[0], v[1], odd_); *(f32x4*)(fq_ + 16) = quad_piece<0xFA>(v[0], v[1], odd_);
                *(f32x4*)(fq_ + 512) = quad_piece<0x50>(v[2], v[3], odd_); *(f32x4*)(fq_ + 528) = quad_piece<0xFA>(v[2], v[3], odd_); }
            cx[0] = nx[0]; cx[1] = nx[1];
#pragma unroll
            for (int k = 0; k < 4; ++k) ce[k] = ne[k];
        }
    }
}

constexpr int NPHASE = 1 + DEPTH * 9;
__global__ void __launch_bounds__(512, 2) mk_fwd(Args a) {
    extern __shared__ __attribute__((aligned(16))) unsigned char lds_raw[];
    LAS unsigned char* lds = (LAS unsigned char*)lds_raw;
    const int tid = threadIdx.x;
    const int G = gridDim.x, c = blockIdx.x;
    unsigned char* ws = a.ws;
    unsigned* ctl = (unsigned*)(ws + WS_CTL);
    if (tid < 64) ((LAS unsigned*)(lds + MISC_OFF))[tid] = 0u;
    __syncthreads();
    const XcdBarrier bar = xcd_barrier_post(ctl + CW_BAR, (volatile LAS unsigned*)(lds + MISC_OFF) + 8);
    const int lo = a.ph_lo, hi = a.ph_hi;
#ifdef REPEAT_PH
#define REP(k) for (int rep_ = 0; rep_ < (((k) == REPEAT_PH) ? 2 : 1); ++rep_)
#else
#define REP(k)
#endif
#define PSTAMP0(k) do {} while (0)
#define PSTAMP1(k) do {} while (0)
#define IN(k) (lo <= (k) && (k) < hi)
#define BAR_AFTER(k) do { if (hi > (k) + 1) xcd_barrier(bar); PSTAMP1(k); } while (0)
    bf16* xb = (bf16*)(ws + WS_XB); bf16* proj = (bf16*)(ws + WS_PROJ); bf16* yb = (bf16*)(ws + WS_Y); bf16* pre = (bf16*)(ws + WS_PRE);
    unsigned char* out2 = ws + WS_OUT2; bf16* qb = (bf16*)(ws + WS_Q); bf16* kvb = (bf16*)(ws + WS_KV);
    bf16* cqn = (bf16*)(ws + WS_CQN); bf16* ckvn = (bf16*)(ws + WS_CKVN); bf16* krope = (bf16*)(ws + WS_KROPE);
    float* cosT = (float*)(ws + WS_ROPE); float* sinT = cosT + SEQ * 16; float* fb = (float*)(ws + WS_FB); float* fz = (float*)(ws + WS_FZ);
    unsigned* list = (unsigned*)(ws + WS_LIST); float* glist = (float*)(ws + WS_GLIST); unsigned* tokinfo = (unsigned*)(ws + WS_TOKINFO);

#ifndef PHMASK
#define PHMASK 0xFFFF
#endif
#define PHON(j) ((PHMASK >> (j)) & 1)
    if (IN(0)) REP(0) { PSTAMP0(0); if (PHON(15)) prologue_phase(a, lds, G, c); BAR_AFTER(0); }
    for (int L = 0; L < DEPTH; ++L) {
        const int pb = 1 + L * 9; const bool odd = (L & 1) != 0; const int li = L >> 1;
        unsigned* cnt = ctl + CW_CNT + L * NEXP * CNT_STRIDE;
        if (IN(pb + 0)) REP(pb + 0) { PSTAMP0(pb + 0);
            if (!odd) { if (PHON(0)) { pg8::DenseOrder S; S.init(NTOK, EVEN_IN, G, c, xb, (bf16*)(ws + WS_EVIN) + (size_t)li * EVEN_IN * 1024, (size_t)256 * DM * 2, (size_t)256 * 1024 * 2);
                pg8::EpiProjEven E{proj};
                pg8::gemm_phase<pg8::EpiProjEven, pg8::DenseOrder, false, true>(lds, 1024, DM, 1024, S, E, nullptr); } }
            else { if (PHON(9)) { pg8::DenseOrder S; S.init(NTOK, ODD_INP, G, c, xb, (bf16*)(ws + WS_ODIN) + (size_t)li * ODD_INP * 1024, (size_t)256 * DM * 2, (size_t)256 * 1024 * 2);
                pg8::EpiProjOdd E{proj, fz};
                pg8::gemm_phase<pg8::EpiProjOdd, pg8::DenseOrder, false, true>(lds, 1024, DM, 1024, S, E, nullptr); } }
            BAR_AFTER(pb + 0);
        }
        if (IN(pb + 1)) REP(pb + 1) { PSTAMP0(pb + 1);
            if (!odd) { if (PHON(1)) sgu_phase(lds, proj, yb, (const bf16*)(ws + WS_SGUW) + (size_t)li * 8 * 128 * 128, a.in[3] + li * 512, a.in[4] + li * 512, a.in[6] + li * 8 * 128, a.in[2] + li * 3 * 512, G, c); }
            else if (PHON(10)) odd_mid_phase(proj, fz, a.in[13] + li * 8, cqn, ckvn, krope, fb, cosT, sinT, ctl + CW_KMAX + L * 64, G, c);
            BAR_AFTER(pb + 1);
        }
        if (odd) {
            if (IN(pb + 2)) REP(pb + 2) { PSTAMP0(pb + 2); if (PHON(2)) {
                pg8::DenseOrder S; S.init(NTOK, 1792, G, c, cqn, (bf16*)(ws + WS_UQT) + (size_t)li * 768 * 256, (size_t)256 * 256 * 2, (size_t)256 * 256 * 2);
                S.nsplit = 3; S.A2 = (const char*)ckvn; S.B2 = (const char*)((bf16*)(ws + WS_UKVT) + (size_t)li * 1024 * 256);
                pg8::EpiQKV E{qb, kvb, cosT, sinT};
                pg8::gemm_phase<pg8::EpiQKV, pg8::DenseOrder, false, true>(lds, 256, 256, 256, S, E, nullptr); }
                BAR_AFTER(pb + 2);
            }
            if (IN(pb + 3)) REP(pb + 3) { PSTAMP0(pb + 3); if (PHON(3)) attn_phase(lds, qb, kvb, krope, proj, fb, yb, ctl + CW_KMAX + L * 64, ctl + CW_AQ + L * 64
#ifdef REPEAT_PH
                + 16 * rep_
#endif
                ); BAR_AFTER(pb + 3); }
        }
        if (IN(pb + 4)) REP(pb + 4) { PSTAMP0(pb + 4); if (PHON(4)) {
            pg8::DenseOrder S; S.init(NTOK, DM, G, c, yb, (odd ? (bf16*)(ws + WS_ODOUT) : (bf16*)(ws + WS_EVOUT)) + (size_t)li * 1024 * 1024, (size_t)256 * DM * 2, (size_t)256 * 1024 * 2);
            pg8::EpiOutProj E{pre};
            pg8::gemm_phase<pg8::EpiOutProj, pg8::DenseOrder, false, true>(lds, 1024, DM, 1024, S, E, nullptr); }
            BAR_AFTER(pb + 4);
        }
        if (IN(pb + 5)) REP(pb + 5) { PSTAMP0(pb + 5);
#ifdef REPEAT_PH
            if (rep_ == 1) ln1_phase(lds, pre, xb, (bf16*)(ws + WS_OUT2), (bf16*)(ws + WS_OUT2 + 128 * MiB), ws + WS_OUT2 + 64 * MiB, a.in[15] + L * DM, a.in[16] + L * DM, (const bf16*)(ws + WS_WRT) + (size_t)L * 2 * NEXP * DM, a.in[20] + L * NEXP, ctl + CW_CNT + 4 * NEXP * CNT_STRIDE, (unsigned*)(ws + WS_OUT2 + 96 * MiB), (float*)(ws + WS_OUT2 + 100 * MiB), (unsigned*)(ws + WS_OUT2 + 104 * MiB), G, c); else
#endif
            if (PHON(5)) ln1_phase(lds, pre, xb, xb, (bf16*)(ws + WS_XL), ws + WS_X8, a.in[15] + L * DM, a.in[16] + L * DM, (const bf16*)(ws + WS_WRT) + (size_t)L * 2 * NEXP * DM, a.in[20] + L * NEXP, cnt, list, glist, tokinfo, G, c);
            BAR_AFTER(pb + 5);
        }
        if (IN(pb + 6)) REP(pb + 6) { PSTAMP0(pb + 6); if (PHON(6)) {
            pg8::MoeOrder S; S.init((LAS unsigned*)(lds + MISC_OFF - 512), cnt, 8, G, c, ws + WS_X8, ws + WS_W1T + (size_t)L * NEXP * 2048 * 1024, (size_t)2048 * 1024, (size_t)256 * 1024, (size_t)DM, true);
            pg8::EpiSwiGLU E{ws + WS_H, (const float*)(ws + WS_B1P) + (size_t)L * NEXP * 2048};
            pg8::gemm_phase<pg8::EpiSwiGLU, pg8::MoeOrder, true, true, true>(lds, 1024, DM, 1024, S, E, list); }
            BAR_AFTER(pb + 6);
        }
        if (IN(pb + 7)) REP(pb + 7) { PSTAMP0(pb + 7); if (PHON(7)) {
            pg8::MoeOrder S; S.init((LAS unsigned*)(lds + MISC_OFF - 512), cnt, 4, G, c, ws + WS_H, ws + WS_W2T + (size_t)L * NEXP * 1024 * 1024, (size_t)1024 * 1024, (size_t)256 * 1024, (size_t)DFF, false);
            pg8::EpiMoeOut E{out2, a.in[24] + (size_t)L * NEXP * DM, glist};
            pg8::gemm_phase<pg8::EpiMoeOut, pg8::MoeOrder, false, true, true>(lds, 1024, DFF, 1024, S, E, nullptr); }
            BAR_AFTER(pb + 7);
        }
        if (IN(pb + 8)) REP(pb + 8) { PSTAMP0(pb + 8);
#ifdef REPEAT_PH
            if (rep_ == 1) ln2_phase(out2, xb, (bf16*)(ws + WS_H), a.in[17] + L * DM, a.in[18] + L * DM, cnt, tokinfo, nullptr, G, c); else
#endif
            if (PHON(8)) ln2_phase(out2, xb, xb, a.in[17] + L * DM, a.in[18] + L * DM, cnt, tokinfo, (L == DEPTH - 1) ? a.out : nullptr, G, c);
            BAR_AFTER(pb + 8);
        }
    }
#undef IN
#undef BAR_AFTER
}

extern "C" void kernel_launch(void* const* d_in, const int* in_sizes, int n_in, void* d_out, int out_size, void* d_ws, size_t ws_size, hipStream_t stream) {
    static int grid = 0;
    if (grid == 0) {
        if (n_in != 25 || out_size != NTOK * DM || ws_size < WS_END) { fprintf(stderr, "kernel_launch: unexpected problem (n_in %d out %d ws %zu)\n", n_in, out_size, ws_size); grid = -1; return; }
        int dev = 0, cus = 0, per_cu = 0;
        if (hipGetDevice(&dev) != hipSuccess || hipDeviceGetAttribute(&cus, hipDeviceAttributeMultiprocessorCount, dev) != hipSuccess) { grid = -1; return; }
        if (hipFuncSetAttribute((const void*)mk_fwd, hipFuncAttributeMaxDynamicSharedMemorySize, LDS_BYTES) != hipSuccess) { fprintf(stderr, "kernel_launch: hipFuncSetAttribute failed\n"); grid = -1; return; }
        if (hipOccupancyMaxActiveBlocksPerMultiprocessor(&per_cu, (const void*)mk_fwd, 512, LDS_BYTES) != hipSuccess || per_cu < 1) { fprintf(stderr, "kernel_launch: occupancy query says %d\n", per_cu); }
        (void)hipGetLastError();
        grid = cus;
    }
    if (grid < 0) return;
    hipMemsetAsync((char*)d_ws + WS_CTL, 0, CTL_ZERO_BYTES, stream);
    Args a{};
    for (int i = 0; i < 25; ++i) a.in[i] = (const float*)d_in[i];
    a.out = (float*)d_out; a.ws = (unsigned char*)d_ws;
#ifndef MK_PER_PHASE
    a.ph_lo = 0; a.ph_hi = NPHASE;
    hipLaunchKernelGGL(mk_fwd, dim3(grid), dim3(512), LDS_BYTES, stream, a);
#else
    for (int p = 0; p < NPHASE; ++p) { a.ph_lo = p; a.ph_hi = p + 1; hipLaunchKernelGGL(mk_fwd, dim3(grid), dim3(512), LDS_BYTES, stream, a); }
#endif
}
```
